# Optimizing an MI355X kernel written in HIP

```python
import jax, jax.numpy as jnp
from jax import lax
import numpy as np

D_MODEL = 1024
BATCH = 32
SEQ = 256
DEPTH = 2
DEC_BATCH = 2
DEC_SEQ = 1024
PAST_LEN = 512

GRID_W = 64
N_EVEN = (DEPTH + 1) // 2
N_ODD = DEPTH // 2
D_FF = 4 * D_MODEL
EPS = 1e-6
D_CONF = D_MODEL // 2
CONF_WIDTH = 31
D_SHORT = D_MODEL // 2
SHORT_WIDTH = 3
EVEN_SPLITS = (D_CONF, D_CONF, D_SHORT, D_SHORT, D_SHORT)
HEAD_DIM = 64
N_Q_HEADS = (D_MODEL // 2) // HEAD_DIM
N_KV_HEADS = 2
Q_PER_KV = N_Q_HEADS // N_KV_HEADS
D_ATT = N_Q_HEADS * HEAD_DIM
D_KV = N_KV_HEADS * HEAD_DIM
WINDOW = 128
BLOCK = 128
ROPE_BASE = 10000.0
N_M_HEADS = (D_MODEL // 2) // HEAD_DIM
D_MLSTM = N_M_HEADS * HEAD_DIM
N_GATES = 4
CHUNK = 128
FORGET_BIAS = 3.0
ODD_SPLITS = (D_ATT, D_KV, D_KV, D_MLSTM, D_MLSTM, D_MLSTM, D_MLSTM, N_GATES * N_M_HEADS)
D_IN_EVEN = sum(EVEN_SPLITS)
D_IN_ODD = sum(ODD_SPLITS)
ATT_SCALE = HEAD_DIM ** -0.5

kernel_name = 'hybrid_diffusion_prefix_step'


def split_cols(x, sizes):
    return jnp.split(x, [int(s) for s in np.cumsum(sizes)[:-1]], axis=-1)


def rmsnorm(x, g):
    xf = x.astype(jnp.float32)
    y = xf * lax.rsqrt(jnp.mean(xf * xf, axis=-1, keepdims=True) + EPS)
    return (y * g.astype(jnp.float32)).astype(x.dtype)


def layernorm(x, g, b):
    xf = x.astype(jnp.float32)
    mu = jnp.mean(xf, axis=-1, keepdims=True)
    var = jnp.mean(jnp.square(xf - mu), axis=-1, keepdims=True)
    y = (xf - mu) * lax.rsqrt(var + EPS) * g.astype(jnp.float32) + b.astype(jnp.float32)
    return y.astype(x.dtype)


def depthwise_conv(x, w):
    k = w.shape[0]
    return lax.conv_general_dilated(x, w[:, None, :].astype(x.dtype), (1,), [(k // 2, k // 2)],
                                    dimension_numbers=('NWC', 'WIO', 'NWC'),
                                    feature_group_count=x.shape[-1])


def modulation(cond, mod_w, mod_b):
    return [m[:, None, :] for m in jnp.split(jax.nn.silu(cond) @ mod_w + mod_b, 6, axis=-1)]


def modulate_in(x, g, shift, scale):
    return rmsnorm(x, g) * (1 + scale) + shift


def gated_out(x, h, g, gate):
    return x + gate * rmsnorm(h, g)


def sq_relu_mlp(h, w1, w2):
    return jnp.square(jax.nn.relu(h @ w1)) @ w2


def even_mixer(h, w_in, conv_a_w, conv_a_b, ln_g, ln_b, conv_b_w, w_out):
    a_val, a_gate, b_gate, c_gate, b_x = split_cols(h @ w_in, EVEN_SPLITS)
    a = a_val * jax.nn.sigmoid(a_gate)
    a = depthwise_conv(a, conv_a_w) + conv_a_b
    a = jax.nn.silu(layernorm(a, ln_g, ln_b))
    s = b_gate * depthwise_conv(c_gate * b_x, conv_b_w)
    return jnp.concatenate([a, s], axis=-1) @ w_out


def axial_rope_tables(t):
    rows = t // GRID_W
    row = jnp.broadcast_to(jnp.arange(rows)[:, None], (rows, GRID_W)).reshape(t).astype(jnp.float32)
    col = jnp.broadcast_to(jnp.arange(GRID_W)[None, :], (rows, GRID_W)).reshape(t).astype(jnp.float32)
    n_freq = HEAD_DIM // 4
    inv_freq = ROPE_BASE ** (-jnp.arange(n_freq, dtype=jnp.float32) / n_freq)
    ang = jnp.concatenate([row[:, None] * inv_freq, col[:, None] * inv_freq], axis=-1)
    return jnp.cos(ang), jnp.sin(ang)


def apply_rope(x, cos, sin):
    half = HEAD_DIM // 2
    xf = x.astype(jnp.float32)
    x1, x2 = xf[..., :half], xf[..., half:]
    c, s = cos[:, None, :], sin[:, None, :]
    return jnp.concatenate([x1 * c - x2 * s, x1 * s + x2 * c], axis=-1).astype(x.dtype)


def sink_column(sink, shape):
    s = sink.reshape(N_KV_HEADS, Q_PER_KV).astype(jnp.float32)[None, :, :, None, None]
    return jnp.broadcast_to(s, shape[:-1] + (1,))


def context_attention(q, k, v, sink):
    b, l = q.shape[:2]
    nb = l // BLOCK
    qb = q.reshape(b, nb, BLOCK, N_KV_HEADS, Q_PER_KV, HEAD_DIM).transpose(1, 0, 2, 3, 4, 5)

    def one_block(qblk):
        s = jnp.einsum('bqhgd,bhkd->bhgqk', qblk, k).astype(jnp.float32) * ATT_SCALE
        p = jax.nn.softmax(jnp.concatenate([s, sink_column(sink, s.shape)], axis=-1), axis=-1)
        return jnp.einsum('bhgqk,bhkd->bqhgd', p[..., :-1].astype(v.dtype), v)

    out = lax.map(one_block, qb)
    return out.transpose(1, 0, 2, 3, 4, 5).reshape(b, l, D_ATT)


def latent_attention(q, k, v, k_ctx, v_ctx, sink):
    b, t = q.shape[:2]
    nb = t // BLOCK
    lc = k_ctx.shape[2]
    qb = q.reshape(b, nb, BLOCK, N_KV_HEADS, Q_PER_KV, HEAD_DIM).transpose(1, 0, 2, 3, 4, 5)
    pad = ((0, 0), (BLOCK, BLOCK), (0, 0), (0, 0))

    def band(a):
        ap = jnp.pad(a, pad).reshape(b, nb + 2, BLOCK, N_KV_HEADS, HEAD_DIM)
        return jnp.concatenate([ap[:, :-2], ap[:, 1:-1], ap[:, 2:]], axis=2).transpose(1, 0, 2, 3, 4)

    qi = jnp.arange(BLOCK)
    kj = jnp.arange(3 * BLOCK)
    band_ok = jnp.abs(kj[None, :] - BLOCK - qi[:, None]) <= WINDOW
    key_pos = (jnp.arange(nb)[:, None] - 1) * BLOCK + kj[None, :]
    mask = band_ok[None] & ((key_pos >= 0) & (key_pos < t))[:, None, :]

    def one_block(args):
        qblk, kblk, vblk, mblk = args
        s_ctx = jnp.einsum('bqhgd,bhkd->bhgqk', qblk, k_ctx).astype(jnp.float32) * ATT_SCALE
        s_lat = jnp.einsum('bqhgd,bkhd->bhgqk', qblk, kblk).astype(jnp.float32) * ATT_SCALE
        s_lat = jnp.where(mblk, s_lat, -jnp.inf)
        logits = jnp.concatenate([s_ctx, s_lat, sink_column(sink, s_lat.shape)], axis=-1)
        p = jax.nn.softmax(logits, axis=-1).astype(v.dtype)
        return (jnp.einsum('bhgqk,bhkd->bqhgd', p[..., :lc], v_ctx)
                + jnp.einsum('bhgqk,bkhd->bqhgd', p[..., lc:lc + 3 * BLOCK], vblk))

    out = lax.map(one_block, (qb, band(k), band(v), mask))
    return out.transpose(1, 0, 2, 3, 4, 5).reshape(b, t, D_ATT)


def mlstm_scan(q, k, v, ig, lf, c0, n0, m0):
    bsz, nh, t, dh = q.shape
    nc = t // CHUNK
    causal = jnp.tril(jnp.ones((CHUNK, CHUNK), dtype=bool))

    def chunks(a):
        return jnp.moveaxis(a.reshape((bsz, nh, nc, CHUNK) + a.shape[3:]), 2, 0)

    def step(carry, xs):
        c_prev, n_prev, m_prev = carry
        qc, kc, vc, igc, lfc = xs
        bcum = jnp.cumsum(lfc, axis=-1)
        log_d = jnp.where(causal, bcum[..., :, None] - bcum[..., None, :] + igc[..., None, :], -jnp.inf)
        log_inter = bcum + m_prev[..., None]
        m_t = jnp.maximum(log_inter, jnp.max(log_d, axis=-1))
        dmat = jnp.exp(log_d - m_t[..., None])
        w_inter = jnp.exp(log_inter - m_t)
        s = jnp.einsum('bhtd,bhsd->bhts', qc, kc) * dmat
        numer = (jnp.einsum('bhts,bhse->bhte', s, vc)
                 + w_inter[..., None] * jnp.einsum('bhtd,bhde->bhte', qc, c_prev))
        denom = jnp.sum(s, axis=-1) + w_inter * jnp.einsum('bhtd,bhd->bht', qc, n_prev)
        h = numer / jnp.maximum(jnp.abs(denom), jnp.exp(-m_t))[..., None]
        b_last = bcum[..., -1]
        log_e = b_last[..., None] - bcum + igc
        m_new = jnp.maximum(b_last + m_prev, jnp.max(log_e, axis=-1))
        e = jnp.exp(log_e - m_new[..., None])
        decay = jnp.exp(b_last + m_prev - m_new)
        c_new = decay[..., None, None] * c_prev + jnp.einsum('bhs,bhsd,bhse->bhde', e, kc, vc)
        n_new = decay[..., None] * n_prev + jnp.einsum('bhs,bhsd->bhd', e, kc)
        return (c_new, n_new, m_new), h

    init = (c0.astype(jnp.float32), n0.astype(jnp.float32), m0.astype(jnp.float32))
    (c, n, m), h = lax.scan(step, init, tuple(chunks(a) for a in (q, k, v, ig, lf)))
    return jnp.moveaxis(h, 0, 2).reshape(bsz, nh, t, dh), (c, n, m)


def mlstm_bidir(qm, km, vm, g, gate_b, init_fwd, init_bwd):
    g = g + gate_b.astype(jnp.float32)[None, :, :, None]
    ig_f, lf_f = g[:, 0], jax.nn.log_sigmoid(g[:, 1])
    ig_b, lf_b = g[:, 2], jax.nn.log_sigmoid(g[:, 3])
    h_f, st_f = mlstm_scan(qm, km, vm, ig_f, lf_f, *init_fwd)
    flip = lambda a: jnp.flip(a, axis=2)
    h_b, st_b = mlstm_scan(flip(qm), flip(km), flip(vm), flip(ig_b), flip(lf_b), *init_bwd)
    return h_f + flip(h_b), st_f, st_b


def mlstm_readout(h, om, hnorm_g, dtype):
    bsz, nh, t, dh = h.shape
    h = h.transpose(0, 2, 1, 3)
    h = h * lax.rsqrt(jnp.mean(h * h, axis=-1, keepdims=True) + EPS) * hnorm_g.astype(jnp.float32).reshape(nh, dh)
    return (h.reshape(bsz, t, D_MLSTM) * jax.nn.sigmoid(om.astype(jnp.float32))).astype(dtype)


def odd_project(h, w_in):
    bsz, t = h.shape[:2]
    qa, ka, va, qm, km, vm, om, g = split_cols(h @ w_in, ODD_SPLITS)
    heads = lambda a: a.reshape(bsz, t, N_M_HEADS, HEAD_DIM).transpose(0, 2, 1, 3).astype(jnp.float32)
    g = g.reshape(bsz, t, N_GATES, N_M_HEADS).transpose(0, 2, 3, 1).astype(jnp.float32)
    return (qa.reshape(bsz, t, N_Q_HEADS, HEAD_DIM), ka.reshape(bsz, t, N_KV_HEADS, HEAD_DIM),
            va.reshape(bsz, t, N_KV_HEADS, HEAD_DIM), heads(qm), heads(km) * HEAD_DIM ** -0.5, heads(vm), om, g)


def odd_mixer_context(h, w_in, sink, gate_b, hnorm_g, w_out):
    bsz = h.shape[0]
    qa, ka, va, qm, km, vm, om, g = odd_project(h, w_in)
    k_ctx = ka.transpose(0, 2, 1, 3)
    v_ctx = va.transpose(0, 2, 1, 3)
    att = context_attention(qa, k_ctx, v_ctx, sink)
    zero = (jnp.zeros((bsz, N_M_HEADS, HEAD_DIM, HEAD_DIM), jnp.float32),
            jnp.zeros((bsz, N_M_HEADS, HEAD_DIM), jnp.float32),
            jnp.zeros((bsz, N_M_HEADS), jnp.float32))
    hm, st_f, st_b = mlstm_bidir(qm, km, vm, g, gate_b, zero, zero)
    y = jnp.concatenate([att, mlstm_readout(hm, om, hnorm_g, h.dtype)], axis=-1) @ w_out
    return y, (k_ctx, v_ctx, st_f[0], st_f[1], st_f[2], st_b[0], st_b[1], st_b[2])


def odd_mixer_latent(h, k_ctx, v_ctx, st_f, st_b, w_in, sink, gate_b, hnorm_g, w_out):
    qa, ka, va, qm, km, vm, om, g = odd_project(h, w_in)
    cos, sin = axial_rope_tables(h.shape[1])
    att = latent_attention(apply_rope(qa, cos, sin), apply_rope(ka, cos, sin), va,
                           k_ctx.astype(h.dtype), v_ctx.astype(h.dtype), sink)
    hm, _, _ = mlstm_bidir(qm, km, vm, g, gate_b, st_f, st_b)
    return jnp.concatenate([att, mlstm_readout(hm, om, hnorm_g, h.dtype)], axis=-1) @ w_out


def setup_inputs(seed: int = 0) -> dict:
    key = jax.random.key(seed)
    ks = list(jax.random.split(key, 40))
    cnt = [0]

    def nrm(shape, s=1.0):
        cnt[0] += 1
        return s * jax.random.normal(ks[cnt[0] - 1], shape, jnp.float32)

    return {
        'x_prompt': nrm((BATCH, SEQ, D_MODEL)),
        'x_sample': nrm((DEC_BATCH, DEC_SEQ, D_MODEL)),
        'c': nrm((DEC_BATCH, D_MODEL)),
        'cache_k': nrm((DEC_BATCH, N_ODD, N_KV_HEADS, PAST_LEN, HEAD_DIM)),
        'cache_v': nrm((DEC_BATCH, N_ODD, N_KV_HEADS, PAST_LEN, HEAD_DIM)),
        'state_c_fwd': nrm((DEC_BATCH, N_ODD, N_M_HEADS, HEAD_DIM, HEAD_DIM), 0.5),
        'state_n_fwd': nrm((DEC_BATCH, N_ODD, N_M_HEADS, HEAD_DIM), 0.5),
        'state_m_fwd': nrm((DEC_BATCH, N_ODD, N_M_HEADS)),
        'state_c_bwd': nrm((DEC_BATCH, N_ODD, N_M_HEADS, HEAD_DIM, HEAD_DIM), 0.5),
        'state_n_bwd': nrm((DEC_BATCH, N_ODD, N_M_HEADS, HEAD_DIM), 0.5),
        'state_m_bwd': nrm((DEC_BATCH, N_ODD, N_M_HEADS)),
        'c_ctx': nrm((D_MODEL,)),
        'mod_w': nrm((DEPTH, D_MODEL, 6 * D_MODEL), 0.5 * D_MODEL ** -0.5),
        'mod_b': nrm((DEPTH, 6 * D_MODEL), 0.02),
        'norm_g': 1.0 + nrm((DEPTH, 4, D_MODEL), 0.05),
        'mlp_w1': nrm((DEPTH, D_MODEL, D_FF), D_MODEL ** -0.5),
        'mlp_w2': nrm((DEPTH, D_FF, D_MODEL), D_FF ** -0.5),
        'even_in_w': nrm((N_EVEN, D_MODEL, D_IN_EVEN), D_MODEL ** -0.5),
        'conv_a_w': nrm((N_EVEN, CONF_WIDTH, D_CONF), CONF_WIDTH ** -0.5),
        'conv_a_b': nrm((N_EVEN, D_CONF), 0.02),
        'ln_a_g': 1.0 + nrm((N_EVEN, D_CONF), 0.05),
        'ln_a_b': nrm((N_EVEN, D_CONF), 0.02),
        'conv_b_w': nrm((N_EVEN, SHORT_WIDTH, D_SHORT), SHORT_WIDTH ** -0.5),
        'even_out_w': nrm((N_EVEN, D_CONF + D_SHORT, D_MODEL), (D_CONF + D_SHORT) ** -0.5),
        'odd_in_w': nrm((N_ODD, D_MODEL, D_IN_ODD), D_MODEL ** -0.5),
        'attn_sink': nrm((N_ODD, N_Q_HEADS)),
        'gate_b': nrm((N_ODD, N_GATES, N_M_HEADS), 0.1)
                  + jnp.array([0.0, FORGET_BIAS, 0.0, FORGET_BIAS], jnp.float32)[None, :, None],
        'hnorm_g': 1.0 + nrm((N_ODD, D_MLSTM), 0.05),
        'odd_out_w': nrm((N_ODD, D_ATT + D_MLSTM, D_MODEL), (D_ATT + D_MLSTM) ** -0.5),
    }


def reference(x_prompt, x_sample, c, cache_k, cache_v, state_c_fwd, state_n_fwd, state_m_fwd,
              state_c_bwd, state_n_bwd, state_m_bwd, c_ctx, mod_w, mod_b, norm_g, mlp_w1, mlp_w2,
              even_in_w, conv_a_w, conv_a_b, ln_a_g, ln_a_b, conv_b_w, even_out_w,
              odd_in_w, attn_sink, gate_b, hnorm_g, odd_out_w):
    yp, ys = x_prompt, x_sample
    new = [[] for _ in range(8)]
    for layer in range(DEPTH):
        j = layer // 2
        g4 = norm_g[layer]
        mp_ = modulation(c_ctx[None, :], mod_w[layer], mod_b[layer])
        ms_ = modulation(c, mod_w[layer], mod_b[layer])
        hp = modulate_in(yp, g4[0], mp_[0], mp_[1])
        hs = modulate_in(ys, g4[0], ms_[0], ms_[1])
        if layer % 2 == 0:
            ep = (even_in_w[j], conv_a_w[j], conv_a_b[j], ln_a_g[j], ln_a_b[j], conv_b_w[j], even_out_w[j])
            op_p = even_mixer(hp, *ep)
            op_s = even_mixer(hs, *ep)
        else:
            od = (odd_in_w[j], attn_sink[j], gate_b[j], hnorm_g[j], odd_out_w[j])
            op_p, st = odd_mixer_context(hp, *od)
            for lst, a in zip(new, st):
                lst.append(a)
            op_s = odd_mixer_latent(hs, cache_k[:, j], cache_v[:, j],
                                    (state_c_fwd[:, j], state_n_fwd[:, j], state_m_fwd[:, j]),
                                    (state_c_bwd[:, j], state_n_bwd[:, j], state_m_bwd[:, j]), *od)
        yp = gated_out(yp, op_p, g4[1], mp_[2])
        ys = gated_out(ys, op_s, g4[1], ms_[2])
        hp = modulate_in(yp, g4[2], mp_[3], mp_[4])
        hs = modulate_in(ys, g4[2], ms_[3], ms_[4])
        yp = gated_out(yp, sq_relu_mlp(hp, mlp_w1[layer], mlp_w2[layer]), g4[3], mp_[5])
        ys = gated_out(ys, sq_relu_mlp(hs, mlp_w1[layer], mlp_w2[layer]), g4[3], ms_[5])
    s = [jnp.stack(lst, axis=1) for lst in new]
    return (yp, ys, s[0], s[1], s[2], s[3], s[4], s[5], s[6], s[7])
```

```cpp
#define MK_ONE_LAUNCH 1
#include <hip/hip_runtime.h>
#include <hip/hip_cooperative_groups.h>
#include <cstdio>
#include <cstdint>
#include <cmath>
namespace cg = cooperative_groups;
namespace pg8 {
#define PG8_LAS __attribute__((address_space(3)))
typedef unsigned short bf16_t;
typedef short bf16x8 __attribute__((ext_vector_type(8)));
typedef float f32x4 __attribute__((ext_vector_type(4)));
typedef unsigned u32x4 __attribute__((ext_vector_type(4)));
constexpr int BM = 256, BK = 64, HALF = 128, HTB = HALF * BK * 2  , STAGE_BYTES = 8 * HTB, NXCD = 8, WGM = 8;

__host__ __device__ __forceinline__ int lds_byte(int r, int c) { const int st = (r >> 4) * 2 + (c >> 5), rr = r & 15, cc = c & 31, ob = rr * 64 + cc * 2; return st * 1024 + (ob ^ (((ob >> 9) & 1) << 5)); }
__host__ __device__ __forceinline__ void stage_rc(int b, int& R, int& C) { const int st = b / 1024, sb = b % 1024, swz = sb ^ (((sb >> 9) & 1) << 5); R = (st >> 1) * 16 + swz / 64; C = (st & 1) * 32 + (swz % 64) / 2; }
__host__ __device__ __forceinline__ int perm32(int rho) { const int n = rho >> 4, i = rho & 15; return 8 * (i >> 2) + 4 * n + (i & 3); }

struct Unit { int pm, pn; };
struct Gemm { const bf16_t* A; const bf16_t* Bt; int M, N, K; };

struct StaticOrder {
    int nM, nN, nwg, G, c;
    __host__ __device__ void init(int M, int N, int G_, int c_) { nM = M / BM; nN = N / BM; nwg = nM * nN; G = G_; c = c_; }
    __host__ __device__ bool next(int i, Unit& u) const {
        const long L = (long)i * G + c; if (L >= nwg) return false;
        int wgid = (int)L; { const int q = nwg / NXCD, r = nwg % NXCD, xcd = wgid % NXCD, off = wgid / NXCD; wgid = (xcd < r ? xcd * (q + 1) : r * (q + 1) + (xcd - r) * q) + off; }
        const int nig = WGM * nN, gid = wgid / nig, fm = gid * WGM, gsz = (nM - fm) < WGM ? (nM - fm) : WGM;
        u.pm = fm + ((wgid % nig) % gsz); u.pn = (wgid % nig) / gsz; return true;
    }
    __device__ __forceinline__ void a_ready(const Unit&) const {}
    __device__ __forceinline__ void done(const Unit&) const {}
};

__device__ __forceinline__ unsigned cvt_pk_bf16(float lo, float hi) { unsigned r; asm volatile("v_cvt_pk_bf16_f32 %0, %1, %2" : "=v"(r) : "v"(lo), "v"(hi)); return r; }
typedef float f32x2 __attribute__((ext_vector_type(2)));
typedef unsigned u32x2 __attribute__((ext_vector_type(2)));
template <int ACT> struct EpiBf16 {
    static constexpr bool PERM = true, AFTER_DRAIN = false;
    bf16_t* O; int ldc;
    __device__ __forceinline__ void operator()(const f32x4 (&acc)[2][2][4][2], const Unit& u, int wr, int wc, int fr, int fq) const {
        const int row0 = u.pm * BM + wr * 64 + fr; const int col0 = u.pn * BM + wc * 32 + 8 * fq;
#pragma unroll
        for (int ai = 0; ai < 2; ++ai)
#pragma unroll
            for (int m = 0; m < 4; ++m) { bf16_t* rowp = O + (size_t)(row0 + ai * HALF + m * 16) * ldc + col0;
#pragma unroll
                for (int bj = 0; bj < 2; ++bj) { f32x4 v0 = acc[ai][bj][m][0], v1 = acc[ai][bj][m][1];
                    if (ACT == 2) {
#pragma unroll
                        for (int q = 0; q < 4; ++q) { float a = fmaxf(v0[q], 0.f), b = fmaxf(v1[q], 0.f); v0[q] = a * a; v1[q] = b * b; }
                    }
                    u32x4 w; w.x = cvt_pk_bf16(v0[0], v0[1]); w.y = cvt_pk_bf16(v0[2], v0[3]); w.z = cvt_pk_bf16(v1[0], v1[1]); w.w = cvt_pk_bf16(v1[2], v1[3]);
                    *(u32x4*)(rowp + bj * HALF) = w; } }
    }
};
struct EpiF32 {
    static constexpr bool PERM = false, AFTER_DRAIN = false;
    float* O; int ldc;
    __device__ __forceinline__ void operator()(const f32x4 (&acc)[2][2][4][2], const Unit& u, int wr, int wc, int fr, int fq) const {
        const int col0 = u.pn * BM + wc * 32 + 4 * fq;
#pragma unroll
        for (int ai = 0; ai < 2; ++ai)
#pragma unroll
            for (int m = 0; m < 4; ++m) { const int r = ai * HALF + wr * 64 + m * 16 + fr; float* rowp = O + (size_t)(u.pm * BM + r) * ldc + col0;
#pragma unroll
                for (int bj = 0; bj < 2; ++bj)
#pragma unroll
                    for (int n = 0; n < 2; ++n) *(f32x4*)(rowp + bj * HALF + n * 16) = acc[ai][bj][m][n]; }
    }
};
template <class Epi, class Sched, bool ALIGN_EPI = false, bool SP2 = false>
__device__ __forceinline__ void gemm_phase(PG8_LAS unsigned char* lds, const Gemm g, const Sched& S, const Epi& E) {
    const int tid = threadIdx.x, wid = __builtin_amdgcn_readfirstlane(tid >> 6), lane = tid & 63, wr = wid >> 2, wc = wid & 3, fr = lane & 15, fq = lane >> 4;
    const int K = g.K, nt = K / BK;
    unsigned voffA[2], voffB[2];
#pragma unroll
    for (int i = 0; i < 2; ++i) { int R, C; stage_rc(tid * 16 + i * 8192, R, C); const int Rb = Epi::PERM ? ((R & ~31) + perm32(R & 31)) : R;
        voffA[i] = (unsigned)(R * K + C) * 2u; voffB[i] = (unsigned)(Rb * K + C) * 2u; }
    const size_t kstep = (size_t)(BK * 2);
    const size_t hstep = (size_t)HALF * K * 2;
    const size_t tstep = 2 * hstep;
    const unsigned ldsw = (unsigned)wid * 1024u;
    const int aoff = lds_byte(wr * 64 + fr, fq * 8), boff = lds_byte(wc * 32 + fr, fq * 8);
#define PG8_SA(b, h) (((b) * 2 + (h)) * HTB)
#define PG8_SB(b, h) ((4 + (b) * 2 + (h)) * HTB)
#define PG8_STAGE(bufoff, gbase, voff) do { _Pragma("unroll") for (int _i = 0; _i < 2; ++_i) \
        __builtin_amdgcn_global_load_lds((const unsigned*)((const char*)(gbase) + (voff)[_i]), (PG8_LAS unsigned*)(lds + (bufoff) + ldsw + _i * 8192), 16, 0, 0); } while (0)
#define PG8_LDA(dst, b, h) do { _Pragma("unroll") for (int m = 0; m < 4; ++m) _Pragma("unroll") for (int k = 0; k < 2; ++k) dst[m][k] = *(const PG8_LAS bf16x8*)(lds + PG8_SA(b, h) + aoff + m * 2048 + k * 1024); } while (0)
#define PG8_LDB(dst, b, h) do { _Pragma("unroll") for (int n = 0; n < 2; ++n) _Pragma("unroll") for (int k = 0; k < 2; ++k) dst[n][k] = *(const PG8_LAS bf16x8*)(lds + PG8_SB(b, h) + boff + n * 2048 + k * 1024); } while (0)
#define PG8_MMA(ai, bj, At, Bt) do { __builtin_amdgcn_s_setprio(1); _Pragma("unroll") for (int m = 0; m < 4; ++m) _Pragma("unroll") for (int n = 0; n < 2; ++n) _Pragma("unroll") for (int k = 0; k < 2; ++k) \
        acc[ai][bj][m][n] = __builtin_amdgcn_mfma_f32_16x16x32_bf16(Bt[n][k], At[m][k], acc[ai][bj][m][n], 0, 0, 0); __builtin_amdgcn_s_setprio(0); } while (0)
#define PG8_WAIT_V(n) asm volatile("s_waitcnt vmcnt(" #n ")" ::: "memory")
#define PG8_WAIT_L(n) asm volatile("s_waitcnt lgkmcnt(" #n ")" ::: "memory")
#define PG8_BAR __builtin_amdgcn_s_barrier()
#define PG8_SCHED __builtin_amdgcn_sched_barrier(0)
    Unit cur, nxt; int ui = 0;
    if (!S.next(0, cur)) return;
    f32x4 acc[2][2][4][2];
#pragma unroll
    for (int a = 0; a < 2; ++a)
#pragma unroll
        for (int b = 0; b < 2; ++b)
#pragma unroll
            for (int m = 0; m < 4; ++m)
#pragma unroll
                for (int n = 0; n < 2; ++n) acc[a][b][m][n] = (f32x4){0.f, 0.f, 0.f, 0.f};
    bf16x8 At[4][2], B0[2][2], B1[2][2];
    const char* cA = (const char*)g.A + (size_t)cur.pm * tstep; const char* cB = (const char*)g.Bt + (size_t)cur.pn * tstep;
    S.a_ready(cur);
    if constexpr (SP2) {
        PG8_STAGE(PG8_SB(0, 0), cB, voffB); PG8_STAGE(PG8_SB(0, 1), cB + hstep, voffB); PG8_STAGE(PG8_SA(0, 0), cA, voffA); PG8_STAGE(PG8_SA(0, 1), cA + hstep, voffA);
        if (wr == 1) PG8_BAR;
        PG8_WAIT_V(2); PG8_BAR;
        PG8_STAGE(PG8_SB(1, 0), cB + kstep, voffB); PG8_STAGE(PG8_SA(1, 0), cA + kstep, voffA); PG8_STAGE(PG8_SB(1, 1), cB + hstep + kstep, voffB);
        PG8_WAIT_V(6); PG8_BAR;
    } else {
        PG8_STAGE(PG8_SB(0, 0), cB, voffB); PG8_STAGE(PG8_SA(0, 0), cA, voffA); PG8_STAGE(PG8_SB(0, 1), cB + hstep, voffB); PG8_STAGE(PG8_SA(0, 1), cA + hstep, voffA);
        if (wr == 1) PG8_BAR;
        PG8_WAIT_V(4); PG8_BAR;
        PG8_STAGE(PG8_SB(1, 0), cB + kstep, voffB); PG8_STAGE(PG8_SA(1, 0), cA + kstep, voffA); PG8_STAGE(PG8_SB(1, 1), cB + hstep + kstep, voffB);
        PG8_WAIT_V(6); PG8_BAR;
    }
    for (;;) {
        const bool has_next = S.next(ui + 1, nxt);
        const char* nA = has_next ? (const char*)g.A + (size_t)nxt.pm * tstep : cA; const char* nB = has_next ? (const char*)g.Bt + (size_t)nxt.pn * tstep : cB;
        for (int t = 0; t < nt; t += 2) {
            const bool last = (t == nt - 2);
            const char* a1 = cA + (size_t)(t + 1) * kstep;
            const char* a2 = last ? nA : cA + (size_t)(t + 2) * kstep; const char* b2 = last ? nB : cB + (size_t)(t + 2) * kstep;
            const char* a3 = a2 + kstep; const char* b3 = b2 + kstep;
            if (last && has_next) S.a_ready(nxt);
            if constexpr (SP2) {
            PG8_LDB(B0, 0, 0); PG8_LDB(B1, 0, 1); PG8_SCHED; PG8_LDA(At, 0, 0); PG8_STAGE(PG8_SA(1, 1), a1 + hstep, voffA);
            PG8_WAIT_V(8); PG8_WAIT_L(0); PG8_BAR; PG8_MMA(0, 0, At, B0); PG8_MMA(0, 1, At, B1); PG8_BAR; PG8_SCHED;
            PG8_LDA(At, 0, 1); PG8_STAGE(PG8_SB(0, 0), b2, voffB); PG8_STAGE(PG8_SB(0, 1), b2 + hstep, voffB); PG8_STAGE(PG8_SA(0, 0), a2, voffA);
            PG8_WAIT_V(8); PG8_WAIT_L(0); PG8_BAR; PG8_MMA(1, 0, At, B0); PG8_MMA(1, 1, At, B1); PG8_BAR; PG8_SCHED;
            PG8_LDB(B0, 1, 0); PG8_LDB(B1, 1, 1); PG8_SCHED; PG8_LDA(At, 1, 0); PG8_STAGE(PG8_SA(0, 1), a2 + hstep, voffA);
            PG8_WAIT_V(8); PG8_WAIT_L(0); PG8_BAR; PG8_MMA(0, 0, At, B0); PG8_MMA(0, 1, At, B1); PG8_BAR; PG8_SCHED;
            PG8_LDA(At, 1, 1); PG8_STAGE(PG8_SB(1, 0), b3, voffB); PG8_STAGE(PG8_SB(1, 1), b3 + hstep, voffB); PG8_STAGE(PG8_SA(1, 0), a3, voffA);
            PG8_WAIT_V(8); PG8_WAIT_L(0); PG8_BAR; PG8_MMA(1, 0, At, B0); PG8_MMA(1, 1, At, B1); PG8_BAR; PG8_SCHED;
            } else {
            PG8_LDB(B0, 0, 0); PG8_SCHED; PG8_LDA(At, 0, 0); PG8_STAGE(PG8_SA(1, 1), a1 + hstep, voffA);
            PG8_WAIT_L(8); PG8_BAR; PG8_WAIT_L(0); PG8_MMA(0, 0, At, B0); PG8_BAR; PG8_SCHED;
            PG8_LDB(B1, 0, 1); PG8_STAGE(PG8_SB(0, 0), b2, voffB);
            PG8_BAR; PG8_WAIT_L(0); PG8_MMA(0, 1, At, B1); PG8_BAR;
            PG8_LDA(At, 0, 1); PG8_STAGE(PG8_SA(0, 0), a2, voffA);
            PG8_BAR; PG8_WAIT_L(0); PG8_MMA(1, 0, At, B0); PG8_BAR; PG8_SCHED;
            PG8_STAGE(PG8_SB(0, 1), b2 + hstep, voffB);
            PG8_WAIT_V(6); PG8_BAR; PG8_MMA(1, 1, At, B1); PG8_BAR;
            PG8_LDB(B0, 1, 0); PG8_SCHED; PG8_LDA(At, 1, 0); PG8_STAGE(PG8_SA(0, 1), a2 + hstep, voffA);
            PG8_WAIT_L(8); PG8_BAR; PG8_WAIT_L(0); PG8_MMA(0, 0, At, B0); PG8_BAR; PG8_SCHED;
            PG8_LDB(B1, 1, 1); PG8_STAGE(PG8_SB(1, 0), b3, voffB);
            PG8_BAR; PG8_WAIT_L(0); PG8_MMA(0, 1, At, B1); PG8_BAR;
            PG8_LDA(At, 1, 1); PG8_STAGE(PG8_SA(1, 0), a3, voffA);
            PG8_BAR; PG8_WAIT_L(0); PG8_MMA(1, 0, At, B0); PG8_BAR; PG8_SCHED;
            PG8_STAGE(PG8_SB(1, 1), b3 + hstep, voffB);
            PG8_WAIT_V(6); PG8_BAR; PG8_MMA(1, 1, At, B1); PG8_BAR;
            }
        }
        if constexpr (ALIGN_EPI) { if (wr == 0) PG8_BAR; }
        if constexpr (!Epi::AFTER_DRAIN) { E(acc, cur, wr, wc, fr, fq); S.done(cur); }
        if (!has_next) break;
#pragma unroll
        for (int a = 0; a < 2; ++a)
#pragma unroll
            for (int b = 0; b < 2; ++b)
#pragma unroll
                for (int m = 0; m < 4; ++m)
#pragma unroll
                    for (int n = 0; n < 2; ++n) acc[a][b][m][n] = (f32x4){0.f, 0.f, 0.f, 0.f};
        cur = nxt; cA = nA; cB = nB; ++ui;
        if constexpr (ALIGN_EPI) { if (wr == 1) PG8_BAR; }
    }
    PG8_WAIT_V(0);
    if constexpr (!ALIGN_EPI) { if (wr == 0) PG8_BAR; }
    PG8_BAR;
    if constexpr (Epi::AFTER_DRAIN) { E.fused(acc, cur, wr, wc, fr, fq, lds, wid, lane); S.done(cur); }
#undef PG8_SA
#undef PG8_SB
#undef PG8_STAGE
#undef PG8_LDA
#undef PG8_LDB
#undef PG8_MMA
#undef PG8_WAIT_V
#undef PG8_WAIT_L
#undef PG8_BAR
#undef PG8_SCHED
}
}
constexpr int NWAVES = 8, NTHR = 512;
constexpr int D = 1024, FF = 4096, MP = 8192, MS = 2048, M = MP + MS;
constexpr int LP = 256, LS = 1024, NBP = 32, NBS = 2;
constexpr int NE = 2560, NO = 2848, NOP = 3072;
constexpr float EPS = 1e-6f;
constexpr int C_QA = 0, C_KA = 512, C_VA = 640, C_QM = 768, C_KM = 1280, C_VM = 1792, C_OM = 2304, C_G = 2816;
constexpr size_t O_YP = 0, O_YS = 8388608, O_CK = 10485760, O_CV = 11534336, O_CF = 12582912, O_NF = 13631488, O_MF = 13647872,
                 O_CB = 13648128, O_NB = 14696704, O_MB = 14713088;
constexpr size_t MiB = 1u << 20;
constexpr size_t WS_MOD = 1 * MiB;
constexpr size_t WS_WEI = 2 * MiB, WS_WEO = 7 * MiB, WS_WOI = 9 * MiB, WS_WOO = 15 * MiB, WS_W1 = 17 * MiB, WS_W2 = 33 * MiB;
constexpr size_t WS_H = 50 * MiB, WS_MIX = 70 * MiB, WS_OP = 90 * MiB, WS_Y = 130 * MiB, WS_ACT = 170 * MiB, WS_END = 250 * MiB;
constexpr int LDS_BYTES = 147456;

#define LAS __attribute__((address_space(3)))
typedef unsigned short bf16;
typedef unsigned v4u __attribute__((ext_vector_type(4)));
typedef unsigned v2u __attribute__((ext_vector_type(2)));
typedef float f32x4 __attribute__((ext_vector_type(4)));
typedef short bf16x8 __attribute__((ext_vector_type(8)));
typedef short bf16x4 __attribute__((ext_vector_type(4)));
__device__ __forceinline__ unsigned f2bf(float f) { unsigned u = __builtin_bit_cast(unsigned, f); return (u + 0x7fffu + ((u >> 16) & 1u)) >> 16; }
__device__ __forceinline__ unsigned pk2(float lo, float hi) { return f2bf(lo) | (f2bf(hi) << 16); }
__device__ __forceinline__ float bflo(unsigned w) { return __uint_as_float(w << 16); }
__device__ __forceinline__ float bfhi(unsigned w) { return __uint_as_float(w & 0xffff0000u); }
__device__ __forceinline__ float bf2f(bf16 b) { return __uint_as_float((unsigned)b << 16); }
__device__ __forceinline__ float wave_sum(float v) {
#pragma unroll
    for (int o = 1; o < 64; o <<= 1) v += __shfl_xor(v, o);
    return v;
}
__device__ __forceinline__ float sigmoidf_(float x) { return 1.f / (1.f + __expf(-x)); }
__device__ __forceinline__ float siluf_(float x) { return x / (1.f + __expf(-x)); }
#define LDS_WAIT() asm volatile("s_waitcnt lgkmcnt(0)" ::: "memory")

struct Args {
    const float* in[29]; float* out; unsigned char* ws; int ph_lo, ph_hi;
};
enum { I_XP = 0, I_XS, I_C, I_CK, I_CV, I_SCF, I_SNF, I_SMF, I_SCB, I_SNB, I_SMB, I_CCTX, I_MODW, I_MODB, I_NORMG, I_W1, I_W2,
       I_EIW, I_CAW, I_CAB, I_LNG, I_LNB, I_CBW, I_EOW, I_OIW, I_SINK, I_GATEB, I_HNG, I_OOW };

__device__ __forceinline__ void p0_transpose_item(const float* W, int K, int N, bf16* WT, LAS float* scr, int item, int lane) {
    const int nblk = N / 32, kb = item / nblk, nb = item % nblk, k0 = 64 * kb, n0 = 32 * nb;
#pragma unroll 8
    for (int i = 0; i < 32; ++i) { const int kk = 2 * i + (lane >> 5); scr[kk * 33 + (lane & 31)] = W[(size_t)(k0 + kk) * N + n0 + (lane & 31)]; }
    LDS_WAIT(); asm volatile("" ::: "memory");
    const int c = lane & 7;
#pragma unroll
    for (int j = 0; j < 4; ++j) { const int n = (lane >> 3) + 8 * j; const LAS float* s = scr + (8 * c) * 33 + n;
        v4u o; o.x = pk2(s[0 * 33], s[1 * 33]); o.y = pk2(s[2 * 33], s[3 * 33]); o.z = pk2(s[4 * 33], s[5 * 33]); o.w = pk2(s[6 * 33], s[7 * 33]);
        *(v4u*)(WT + (size_t)(n0 + n) * K + k0 + 8 * c) = o; }
    LDS_WAIT(); asm volatile("" ::: "memory");
}

__device__ __forceinline__ void phase_p0(const Args& A, LAS unsigned char* lds) {
    const int tid = threadIdx.x, lane = tid & 63, wave = tid >> 6;
    const int G = gridDim.x, gw = blockIdx.x * NWAVES + wave, NGW = G * NWAVES;
    unsigned char* ws = A.ws;
    LAS float* scr = (LAS float*)(lds + wave * 16384);
    constexpr int IT_EI = 16 * (NE / 32), IT_EO = 16 * 32, IT_OI = 16 * (NO / 32), IT_OO = 16 * 32, IT_1 = 16 * (FF / 32), IT_2 = 64 * 32;
    constexpr int NIT = IT_EI + IT_EO + IT_OI + IT_OO + 2 * IT_1 + 2 * IT_2;
    for (int it = gw; it < NIT; it += NGW) {
        int r = it;
        if (r < IT_EI) { p0_transpose_item(A.in[I_EIW], D, NE, (bf16*)(ws + WS_WEI), scr, r, lane); continue; } r -= IT_EI;
        if (r < IT_EO) { p0_transpose_item(A.in[I_EOW], D, D, (bf16*)(ws + WS_WEO), scr, r, lane); continue; } r -= IT_EO;
        if (r < IT_OI) { p0_transpose_item(A.in[I_OIW], D, NO, (bf16*)(ws + WS_WOI), scr, r, lane); continue; } r -= IT_OI;
        if (r < IT_OO) { p0_transpose_item(A.in[I_OOW], D, D, (bf16*)(ws + WS_WOO), scr, r, lane); continue; } r -= IT_OO;
        if (r < IT_1) { p0_transpose_item(A.in[I_W1], D, FF, (bf16*)(ws + WS_W1), scr, r, lane); continue; } r -= IT_1;
        if (r < IT_1) { p0_transpose_item(A.in[I_W1] + (size_t)D * FF, D, FF, (bf16*)(ws + WS_W1 + 8 * MiB), scr, r, lane); continue; } r -= IT_1;
        if (r < IT_2) { p0_transpose_item(A.in[I_W2], FF, D, (bf16*)(ws + WS_W2), scr, r, lane); continue; } r -= IT_2;
        p0_transpose_item(A.in[I_W2] + (size_t)D * FF, FF, D, (bf16*)(ws + WS_W2 + 8 * MiB), scr, r, lane);
    }
    { v4u z = {0u, 0u, 0u, 0u}; v4u* p = (v4u*)(ws + WS_WOI + (size_t)NO * D * 2); const int n16 = (NOP - NO) * D * 2 / 16;
      for (int i = blockIdx.x * NTHR + tid; i < n16; i += G * NTHR) p[i] = z; }
    __syncthreads();
    LAS float* sc = (LAS float*)lds;
    LAS float* red = (LAS float*)(lds + 16384);
    for (int i = tid; i < 3 * D; i += NTHR) { const int r = i / D, k = i % D; const float c = (r == 0) ? A.in[I_CCTX][k] : A.in[I_C][(r - 1) * D + k]; sc[i] = siluf_(c); }
    __syncthreads();
    float* MOD = (float*)(ws + WS_MOD);
    for (int un = blockIdx.x; un < 2 * 96; un += G) {
        const int l = un / 96, cgp = un % 96, cq = tid & 15, kg = tid >> 4;
        const float* Wp = A.in[I_MODW] + (size_t)l * D * 6144 + (size_t)(kg * 32) * 6144 + cgp * 64 + cq * 4;
        f32x4 a0 = {0.f, 0.f, 0.f, 0.f}, a1 = a0, a2 = a0;
#pragma unroll 8
        for (int k = 0; k < 32; ++k) { const f32x4 w = *(const f32x4*)(Wp + (size_t)k * 6144); const int kk = kg * 32 + k;
            a0 += w * sc[kk]; a1 += w * sc[D + kk]; a2 += w * sc[2 * D + kk]; }
        *(LAS f32x4*)(red + (kg * 3 + 0) * 64 + cq * 4) = a0; *(LAS f32x4*)(red + (kg * 3 + 1) * 64 + cq * 4) = a1; *(LAS f32x4*)(red + (kg * 3 + 2) * 64 + cq * 4) = a2;
        __syncthreads();
        if (tid < 192) { const int r = tid >> 6, c = tid & 63; float s = 0.f;
#pragma unroll 8
            for (int k = 0; k < 32; ++k) s += red[(k * 3 + r) * 64 + c];
            MOD[(size_t)(l * 3 + r) * 6144 + cgp * 64 + c] = s + A.in[I_MODB][l * 6144 + cgp * 64 + c]; }
        __syncthreads();
    }
}

__device__ __forceinline__ int cond_of_row(int row) { return row < MP ? 0 : (row < MP + LS ? 1 : 2); }
__device__ __forceinline__ void norm_mod_store(const f32x4 (&v)[4], const float* g, const float* shift, const float* scale, bf16* hrow, int lane) {
    float s = 0.f;
#pragma unroll
    for (int j = 0; j < 4; ++j) s += (v[j].x * v[j].x + v[j].y * v[j].y) + (v[j].z * v[j].z + v[j].w * v[j].w);
    const float rstd = rsqrtf(wave_sum(s) * (1.f / D) + EPS);
#pragma unroll
    for (int j = 0; j < 4; ++j) { const int c = 4 * lane + 256 * j;
        const f32x4 gg = *(const f32x4*)(g + c), sh = *(const f32x4*)(shift + c), sl = *(const f32x4*)(scale + c);
        const f32x4 o = (v[j] * rstd) * gg * (sl + 1.f) + sh;
        v2u w; w.x = pk2(o.x, o.y); w.y = pk2(o.z, o.w); *(v2u*)(hrow + c) = w; }
}
__device__ __forceinline__ void phase_prenorm0(const Args& A) {
    const int lane = threadIdx.x & 63, gw = blockIdx.x * NWAVES + (threadIdx.x >> 6), NGW = gridDim.x * NWAVES;
    const float* MOD = (const float*)(A.ws + WS_MOD); bf16* H = (bf16*)(A.ws + WS_H);
    for (int row = gw; row < M; row += NGW) {
        const float* xr = row < MP ? A.in[I_XP] + (size_t)row * D : A.in[I_XS] + (size_t)(row - MP) * D;
        f32x4 v[4];
#pragma unroll
        for (int j = 0; j < 4; ++j) v[j] = *(const f32x4*)(xr + 4 * lane + 256 * j);
        const float* md = MOD + (size_t)cond_of_row(row) * 6144;
        norm_mod_store(v, A.in[I_NORMG], md, md + D, H + (size_t)row * D, lane);
    }
}
__device__ __forceinline__ void phase_post(const Args& A, int l, int which) {
    const int lane = threadIdx.x & 63, gw = blockIdx.x * NWAVES + (threadIdx.x >> 6), NGW = gridDim.x * NWAVES;
    const float* MOD = (const float*)(A.ws + WS_MOD); bf16* H = (bf16*)(A.ws + WS_H);
    const float* OP = (const float*)(A.ws + WS_OP); float* Y = (float*)(A.ws + WS_Y);
    const float* gA = A.in[I_NORMG] + (size_t)(l * 4 + (which == 0 ? 1 : 3)) * D;
    for (int row = gw; row < M; row += NGW) {
        const float* rr; float* yo;
        if (l == 0 && which == 0) rr = row < MP ? A.in[I_XP] + (size_t)row * D : A.in[I_XS] + (size_t)(row - MP) * D; else rr = Y + (size_t)row * D;
        if (l == 1 && which == 1) yo = A.out + (size_t)row * D; else yo = Y + (size_t)row * D;
        const float* md = MOD + (size_t)(l * 3 + cond_of_row(row)) * 6144;
        const float* gate = md + (which == 0 ? 2 * D : 5 * D);
        f32x4 o[4], r[4]; float s = 0.f;
#pragma unroll
        for (int j = 0; j < 4; ++j) { o[j] = *(const f32x4*)(OP + (size_t)row * D + 4 * lane + 256 * j); r[j] = *(const f32x4*)(rr + 4 * lane + 256 * j);
            s += (o[j].x * o[j].x + o[j].y * o[j].y) + (o[j].z * o[j].z + o[j].w * o[j].w); }
        const float rstd = rsqrtf(wave_sum(s) * (1.f / D) + EPS);
#pragma unroll
        for (int j = 0; j < 4; ++j) { const int c = 4 * lane + 256 * j; const f32x4 gg = *(const f32x4*)(gA + c), gt = *(const f32x4*)(gate + c);
            r[j] = r[j] + gt * ((o[j] * rstd) * gg); *(f32x4*)(yo + c) = r[j]; }
        if (which == 0) norm_mod_store(r, A.in[I_NORMG] + (size_t)(l * 4 + 2) * D, md + 3 * D, md + 4 * D, H + (size_t)row * D, lane);
        else if (l == 0) { const float* md1 = MOD + (size_t)(3 + cond_of_row(row)) * 6144; norm_mod_store(r, A.in[I_NORMG] + (size_t)4 * D, md1, md1 + D, H + (size_t)row * D, lane); }
    }
}

__device__ __forceinline__ void phase_even_mixer(const Args& A, LAS unsigned char* lds) {
    const int tid = threadIdx.x, lane = tid & 63, wave = tid >> 6, ch = tid;
    const bf16* U = (const bf16*)(A.ws + WS_ACT); bf16* MIX = (bf16*)(A.ws + WS_MIX);
    LAS float* cv = (LAS float*)lds;
    float w[31];
#pragma unroll
    for (int k = 0; k < 31; ++k) w[k] = A.in[I_CAW][k * 512 + ch];
    const float cbias = A.in[I_CAB][ch];
    const float wb0 = A.in[I_CBW][ch], wb1 = A.in[I_CBW][512 + ch], wb2 = A.in[I_CBW][1024 + ch];
    for (int tile = blockIdx.x; tile < M / 16; tile += gridDim.x) {
        const int t0 = tile * 16;
        int s0, L; if (t0 < MP) { s0 = t0 & ~(LP - 1); L = LP; } else { s0 = MP + ((t0 - MP) & ~(LS - 1)); L = LS; }
        float acc[16];
#pragma unroll
        for (int t = 0; t < 16; ++t) acc[t] = cbias;
#pragma unroll
        for (int r = 0; r < 46; ++r) {
            const int row = t0 - 15 + r; float v = 0.f;
            if (row >= s0 && row < s0 + L) { const bf16* up = U + (size_t)row * NE + ch; v = bf2f(up[0]) * sigmoidf_(bf2f(up[512])); }
#pragma unroll
            for (int t = 0; t < 16; ++t) { const int k = r - t; if (k >= 0 && k <= 30) acc[t] += w[k] * v; }
        }
#pragma unroll
        for (int t = 0; t < 16; ++t) cv[t * 512 + ch] = acc[t];
        {
            float cb[18];
#pragma unroll
            for (int r = 0; r < 18; ++r) { const int row = t0 - 1 + r; float v = 0.f;
                if (row >= s0 && row < s0 + L) { const bf16* up = U + (size_t)row * NE + ch; v = bf2f(up[1536]) * bf2f(up[2048]); } cb[r] = v; }
#pragma unroll
            for (int t = 0; t < 16; ++t) { const float bg = bf2f(U[(size_t)(t0 + t) * NE + 1024 + ch]);
                const float sv = bg * (wb0 * cb[t] + wb1 * cb[t + 1] + wb2 * cb[t + 2]);
                MIX[(size_t)(t0 + t) * D + 512 + ch] = (bf16)f2bf(sv); }
        }
        __syncthreads();
#pragma unroll
        for (int tt = 0; tt < 2; ++tt) { const int t = wave * 2 + tt;
            const f32x4 x0 = *(LAS f32x4*)(cv + t * 512 + lane * 8), x1 = *(LAS f32x4*)(cv + t * 512 + lane * 8 + 4);
            const float mu = wave_sum((x0.x + x0.y) + (x0.z + x0.w) + (x1.x + x1.y) + (x1.z + x1.w)) * (1.f / 512.f);
            const f32x4 d0 = x0 - mu, d1 = x1 - mu;
            const float var = wave_sum((d0.x * d0.x + d0.y * d0.y) + (d0.z * d0.z + d0.w * d0.w) + (d1.x * d1.x + d1.y * d1.y) + (d1.z * d1.z + d1.w * d1.w)) * (1.f / 512.f);
            const float rstd = rsqrtf(var + EPS);
            const f32x4 g0 = *(const f32x4*)(A.in[I_LNG] + lane * 8), g1 = *(const f32x4*)(A.in[I_LNG] + lane * 8 + 4);
            const f32x4 b0 = *(const f32x4*)(A.in[I_LNB] + lane * 8), b1 = *(const f32x4*)(A.in[I_LNB] + lane * 8 + 4);
            const f32x4 y0 = d0 * rstd * g0 + b0, y1 = d1 * rstd * g1 + b1;
            v4u o; o.x = pk2(siluf_(y0.x), siluf_(y0.y)); o.y = pk2(siluf_(y0.z), siluf_(y0.w)); o.z = pk2(siluf_(y1.x), siluf_(y1.y)); o.w = pk2(siluf_(y1.z), siluf_(y1.w));
            *(v4u*)(MIX + (size_t)(t0 + t) * D + lane * 8) = o; }
        __syncthreads();
    }
}
#define MFMA16(a, b, c) __builtin_amdgcn_mfma_f32_16x16x32_bf16((a), (b), (c), 0, 0, 0)
__device__ __forceinline__ bf16x8 cat44(v2u lo, v2u hi) { v4u w; w.x = lo.x; w.y = lo.y; w.z = hi.x; w.w = hi.y; return __builtin_bit_cast(bf16x8, w); }
__device__ __forceinline__ float logsigmoidf_(float x) { return fminf(x, 0.f) - log1pf(__expf(-fabsf(x))); }

constexpr int ML_K = 0, ML_VT = 18432, ML_KT = ML_VT + 21760, ML_CT = ML_KT + 17408, ML_A = ML_CT + 11520, ML_M = ML_A + 512, ML_MT = ML_M + 512,
              ML_E = ML_MT + 512, ML_WI = ML_E + 512, ML_SC = ML_WI + 512, ML_END = ML_SC + 64;
__device__ __forceinline__ void mlstm_unit(const Args& A, LAS unsigned char* lds, int latent, int b, int h, int dir) {
    const int tid = threadIdx.x, lane = tid & 63, wave = __builtin_amdgcn_readfirstlane(tid >> 6), fr = lane & 15, fg = lane >> 4;
    const bf16* U = (const bf16*)(A.ws + WS_ACT); float* HD = (float*)(A.ws + WS_OP) + (size_t)dir * M * 512;
    const int T = latent ? LS : LP, nc = T / 128, rowbase = latent ? MP + b * LS : b * LP;
    LAS float* la = (LAS float*)(lds + ML_A); LAS float* lM = (LAS float*)(lds + ML_M); LAS float* lmt = (LAS float*)(lds + ML_MT);
    LAS float* le = (LAS float*)(lds + ML_E); LAS float* lwi = (LAS float*)(lds + ML_WI); LAS float* lsc = (LAS float*)(lds + ML_SC);
    f32x4 accC[3];
    float m_prev = 0.f;
    if (latent) m_prev = A.in[dir ? I_SMB : I_SMF][b * 8 + h];
#pragma unroll
    for (int k = 0; k < 3; ++k) { accC[k] = (f32x4){0.f, 0.f, 0.f, 0.f}; const int id = wave + 8 * k;
        if (latent && id < 20) { const int dt = id & 3, et = id >> 2; const int e = 16 * et + fr;
            const float* c0 = A.in[dir ? I_SCB : I_SCF] + (size_t)(b * 8 + h) * 4096; const float* n0 = A.in[dir ? I_SNB : I_SNF] + (size_t)(b * 8 + h) * 64;
#pragma unroll
            for (int i = 0; i < 4; ++i) { const int d = 16 * dt + 4 * fg + i; accC[k][i] = (e < 64) ? c0[d * 64 + e] : (e == 64 ? n0[d] : 0.f); } }
    }
    for (int i = tid; i < 16 * 136; i += NTHR) { const int r = i / 136, c = i % 136; *(LAS bf16*)(lds + ML_VT + (64 + r) * 272 + c * 2) = (r == 0) ? (bf16)0x3F80 : (bf16)0; }
#pragma unroll
    for (int k = 0; k < 3; ++k) { const int id = wave + 8 * k;
        if (id < 20) { const int dt = id & 3, et = id >> 2; v2u w; w.x = pk2(accC[k][0], accC[k][1]); w.y = pk2(accC[k][2], accC[k][3]);
            *(LAS v2u*)(lds + ML_CT + (16 * et + fr) * 144 + (16 * dt + 4 * fg) * 2) = w; } }
    const int gi = dir ? 2 : 0;
    const float gb_i = A.in[I_GATEB][gi * 8 + h], gb_f = A.in[I_GATEB][(gi + 1) * 8 + h];

    for (int c = 0; c < nc; ++c) {
        const int ks = tid >> 2, kpart = tid & 3;
        const int krow = rowbase + (dir ? T - 1 - (c * 128 + ks) : c * 128 + ks);
        unsigned kreg[8];
        { const v4u k0 = *(const v4u*)(U + (size_t)krow * NOP + C_KM + h * 64 + 16 * kpart), k1 = *(const v4u*)(U + (size_t)krow * NOP + C_KM + h * 64 + 16 * kpart + 8);
          const unsigned kin[8] = {k0.x, k0.y, k0.z, k0.w, k1.x, k1.y, k1.z, k1.w};
#pragma unroll
          for (int j = 0; j < 8; ++j) kreg[j] = pk2(bflo(kin[j]) * 0.125f, bfhi(kin[j]) * 0.125f);
          v4u o0 = {kreg[0], kreg[1], kreg[2], kreg[3]}, o1 = {kreg[4], kreg[5], kreg[6], kreg[7]};
          *(LAS v4u*)(lds + ML_K + ks * 144 + 32 * kpart) = o0; *(LAS v4u*)(lds + ML_K + ks * 144 + 32 * kpart + 16) = o1; }
        { const int vs = tid & 127, vpart = tid >> 7; const int vrow = rowbase + (dir ? T - 1 - (c * 128 + vs) : c * 128 + vs);
          const v4u v0 = *(const v4u*)(U + (size_t)vrow * NOP + C_VM + h * 64 + 16 * vpart), v1 = *(const v4u*)(U + (size_t)vrow * NOP + C_VM + h * 64 + 16 * vpart + 8);
          const unsigned vin[8] = {v0.x, v0.y, v0.z, v0.w, v1.x, v1.y, v1.z, v1.w};
#pragma unroll
          for (int j = 0; j < 8; ++j) { *(LAS bf16*)(lds + ML_VT + (16 * vpart + 2 * j) * 272 + vs * 2) = (bf16)(vin[j] & 0xffffu);
                                         *(LAS bf16*)(lds + ML_VT + (16 * vpart + 2 * j + 1) * 272 + vs * 2) = (bf16)(vin[j] >> 16); } }
        const int tq = 16 * wave + fr; const int qrow = rowbase + (dir ? T - 1 - (c * 128 + tq) : c * 128 + tq);
        const bf16x8 qb0 = *(const bf16x8*)(U + (size_t)qrow * NOP + C_QM + h * 64 + 8 * fg), qb1 = *(const bf16x8*)(U + (size_t)qrow * NOP + C_QM + h * 64 + 32 + 8 * fg);
        if (wave == 0) {
            float ig[2], lf[2];
#pragma unroll
            for (int q = 0; q < 2; ++q) { const int tau = 2 * lane + q; const int grow = rowbase + (dir ? T - 1 - (c * 128 + tau) : c * 128 + tau);
                ig[q] = bf2f(U[(size_t)grow * NOP + C_G + gi * 8 + h]) + gb_i; lf[q] = logsigmoidf_(bf2f(U[(size_t)grow * NOP + C_G + (gi + 1) * 8 + h]) + gb_f); }
            const float pairsum = lf[0] + lf[1]; float sc = pairsum;
#pragma unroll
            for (int o = 1; o < 64; o <<= 1) { const float t = __shfl_up(sc, o); if (lane >= o) sc += t; }
            const float excl = sc - pairsum; const float bc0 = excl + lf[0], bc1 = excl + pairsum;
            const float a0 = ig[0] - bc0, a1 = ig[1] - bc1; const float pm1 = fmaxf(a0, a1); float pmx = pm1;
#pragma unroll
            for (int o = 1; o < 64; o <<= 1) { const float t = __shfl_up(pmx, o); if (lane >= o) pmx = fmaxf(pmx, t); }
            float pex = __shfl_up(pmx, 1); if (lane == 0) pex = -INFINITY;
            const float p0 = fmaxf(pex, a0), p1 = fmaxf(pex, pm1);
            const float M0 = fmaxf(m_prev, p0), M1 = fmaxf(m_prev, p1);
            const float blast = __shfl(bc1, 63), Mlast = __shfl(M1, 63);
            la[2 * lane] = a0; la[2 * lane + 1] = a1; lM[2 * lane] = M0; lM[2 * lane + 1] = M1; lmt[2 * lane] = bc0 + M0; lmt[2 * lane + 1] = bc1 + M1;
            le[2 * lane] = __expf(a0 - Mlast); le[2 * lane + 1] = __expf(a1 - Mlast); lwi[2 * lane] = __expf(m_prev - M0); lwi[2 * lane + 1] = __expf(m_prev - M1);
            if (lane == 0) lsc[0] = __expf(m_prev - Mlast);
            m_prev = blast + Mlast;
        }
        __syncthreads();
        {
            const float Mt = lM[tq], mtt = lmt[tq], wit = lwi[tq];
            f32x4 accN[5], accI[5];
#pragma unroll
            for (int et = 0; et < 5; ++et) { accN[et] = (f32x4){0.f, 0.f, 0.f, 0.f}; accI[et] = accN[et]; }
            for (int sp = 0; sp <= (wave >> 1); ++sp) {
                f32x4 S[2];
#pragma unroll
                for (int q = 0; q < 2; ++q) { const int st = 2 * sp + q; S[q] = (f32x4){0.f, 0.f, 0.f, 0.f};
                    if (st <= wave) {
                        const bf16x8 ka0 = *(LAS bf16x8*)(lds + ML_K + (16 * st + fr) * 144 + 16 * fg), ka1 = *(LAS bf16x8*)(lds + ML_K + (16 * st + fr) * 144 + 64 + 16 * fg);
                        S[q] = MFMA16(ka0, qb0, S[q]); S[q] = MFMA16(ka1, qb1, S[q]);
                        const f32x4 av = *(LAS f32x4*)(la + 16 * st + 4 * fg);
#pragma unroll
                        for (int i = 0; i < 4; ++i) { const int s = 16 * st + 4 * fg + i; S[q][i] = (s <= tq) ? S[q][i] * __expf(av[i] - Mt) : 0.f; }
                    } }
                v2u plo, phi; plo.x = pk2(S[0][0], S[0][1]); plo.y = pk2(S[0][2], S[0][3]); phi.x = pk2(S[1][0], S[1][1]); phi.y = pk2(S[1][2], S[1][3]);
                const bf16x8 pb = cat44(plo, phi);
#pragma unroll
                for (int et = 0; et < 5; ++et) { const LAS unsigned char* vp = lds + ML_VT + (16 * et + fr) * 272;
                    const v2u a_lo = *(const LAS v2u*)(vp + (32 * sp + 4 * fg) * 2), a_hi = *(const LAS v2u*)(vp + (32 * sp + 16 + 4 * fg) * 2);
                    accN[et] = MFMA16(cat44(a_lo, a_hi), pb, accN[et]); }
            }
#pragma unroll
            for (int et = 0; et < 5; ++et) { const LAS unsigned char* cp = lds + ML_CT + (16 * et + fr) * 144;
                const bf16x8 c0 = *(const LAS bf16x8*)(cp + 16 * fg), c1 = *(const LAS bf16x8*)(cp + 64 + 16 * fg);
                accI[et] = MFMA16(c0, qb0, accI[et]); accI[et] = MFMA16(c1, qb1, accI[et]); }
            float den = accN[4][0] + wit * accI[4][0]; den = __shfl(den, fr);
            const float hd = 1.f / fmaxf(fabsf(den), __expf(-mtt));
            float* hp = HD + (size_t)qrow * 512 + h * 64 + 4 * fg;
#pragma unroll
            for (int et = 0; et < 4; ++et) { f32x4 o = (accN[et] + accI[et] * wit) * hd; *(f32x4*)(hp + 16 * et) = o; }
        }
        { const float es = le[ks];
#pragma unroll
          for (int j = 0; j < 8; ++j) { *(LAS bf16*)(lds + ML_KT + (16 * kpart + 2 * j) * 272 + ks * 2) = (bf16)f2bf(bflo(kreg[j]) * es);
                                         *(LAS bf16*)(lds + ML_KT + (16 * kpart + 2 * j + 1) * 272 + ks * 2) = (bf16)f2bf(bfhi(kreg[j]) * es); } }
        __syncthreads();
        { const float decay = lsc[0];
#pragma unroll
          for (int k = 0; k < 3; ++k) { const int id = wave + 8 * k;
            if (id < 20) { const int dt = id & 3, et = id >> 2; accC[k] = accC[k] * decay;
#pragma unroll
                for (int sk = 0; sk < 4; ++sk) { const bf16x8 ka = *(const LAS bf16x8*)(lds + ML_KT + (16 * dt + fr) * 272 + (32 * sk + 8 * fg) * 2);
                    const bf16x8 vb = *(const LAS bf16x8*)(lds + ML_VT + (16 * et + fr) * 272 + (32 * sk + 8 * fg) * 2); accC[k] = MFMA16(ka, vb, accC[k]); }
                v2u w; w.x = pk2(accC[k][0], accC[k][1]); w.y = pk2(accC[k][2], accC[k][3]);
                *(LAS v2u*)(lds + ML_CT + (16 * et + fr) * 144 + (16 * dt + 4 * fg) * 2) = w; } } }
        __syncthreads();
    }
    if (!latent) {
        float* oc = A.out + (dir ? O_CB : O_CF) + (size_t)(b * 8 + h) * 4096; float* on = A.out + (dir ? O_NB : O_NF) + (size_t)(b * 8 + h) * 64;
#pragma unroll
        for (int k = 0; k < 3; ++k) { const int id = wave + 8 * k;
            if (id < 20) { const int dt = id & 3, et = id >> 2; const int e = 16 * et + fr;
#pragma unroll
                for (int i = 0; i < 4; ++i) { const int d = 16 * dt + 4 * fg + i; if (e < 64) oc[d * 64 + e] = accC[k][i]; else if (e == 64) on[d] = accC[k][i]; } } }
        if (tid == 0) A.out[(dir ? O_MB : O_MF) + b * 8 + h] = m_prev;
    }
}

constexpr int AT_K = 0, AT_VT = 9216, AT_END = 18432;
__device__ __forceinline__ void rope_freqs(float (&f)[8], int base) {
#pragma unroll
    for (int j = 0; j < 8; ++j) f[j] = exp2f(-(float)((base + j) & 15) * (13.287712379549449f / 16.f));
}
__device__ __forceinline__ void attn_unit(const Args& A, LAS unsigned char* lds, int latent, int b, int hq, int qb) {
    const int tid = threadIdx.x, lane = tid & 63, wave = __builtin_amdgcn_readfirstlane(tid >> 6), fr = lane & 15, fg = lane >> 4;
    const bf16* U = (const bf16*)(A.ws + WS_ACT); bf16* MIX = (bf16*)(A.ws + WS_MIX);
    const int kv = hq >> 2, rowbase = latent ? MP + b * LS : b * LP;
    const int qpos = qb * 128 + 16 * wave + fr, qrow = rowbase + qpos;
    bf16x8 qb0, qb1;
    {
        const v4u q0 = *(const v4u*)(U + (size_t)qrow * NOP + C_QA + hq * 64 + 8 * fg), q1 = *(const v4u*)(U + (size_t)qrow * NOP + C_QA + hq * 64 + 32 + 8 * fg);
        const unsigned a[4] = {q0.x, q0.y, q0.z, q0.w}, c[4] = {q1.x, q1.y, q1.z, q1.w};
        float x1[8], x2[8];
#pragma unroll
        for (int j = 0; j < 4; ++j) { x1[2 * j] = bflo(a[j]); x1[2 * j + 1] = bfhi(a[j]); x2[2 * j] = bflo(c[j]); x2[2 * j + 1] = bfhi(c[j]); }
        if (latent) { float fq[8]; rope_freqs(fq, 8 * fg); const float p = (fg < 2) ? (float)(qpos >> 6) : (float)(qpos & 63);
#pragma unroll
            for (int j = 0; j < 8; ++j) { float sn, cs; sincosf(p * fq[j], &sn, &cs); const float y1 = x1[j] * cs - x2[j] * sn, y2 = x1[j] * sn + x2[j] * cs; x1[j] = y1; x2[j] = y2; } }
        v4u o0, o1; o0.x = pk2(x1[0] * 0.125f, x1[1] * 0.125f); o0.y = pk2(x1[2] * 0.125f, x1[3] * 0.125f); o0.z = pk2(x1[4] * 0.125f, x1[5] * 0.125f); o0.w = pk2(x1[6] * 0.125f, x1[7] * 0.125f);
        o1.x = pk2(x2[0] * 0.125f, x2[1] * 0.125f); o1.y = pk2(x2[2] * 0.125f, x2[3] * 0.125f); o1.z = pk2(x2[4] * 0.125f, x2[5] * 0.125f); o1.w = pk2(x2[6] * 0.125f, x2[7] * 0.125f);
        qb0 = __builtin_bit_cast(bf16x8, o0); qb1 = __builtin_bit_cast(bf16x8, o1);
    }
    f32x4 O[4];
#pragma unroll
    for (int dt = 0; dt < 4; ++dt) O[dt] = (f32x4){0.f, 0.f, 0.f, 0.f};
    float m_run = -1e30f, l_run = 0.f;
    const int nctx = latent ? 8 : 0;
    const int lat0 = latent ? (qb > 0 ? (qb - 1) * 2 : 0) : 0, lat1 = latent ? ((qb + 2) * 2 < LS / 64 ? (qb + 2) * 2 : LS / 64) : LP / 64;
    const int ntiles = nctx + (lat1 - lat0);
    for (int ti = 0; ti < ntiles; ++ti) {
        const bool from_cache = ti < nctx; const int kt = from_cache ? ti : lat0 + (ti - nctx);
        { const int key = tid >> 3, cc = tid & 7; float x1[4], x2[4];
          if (from_cache) { const float* kp = A.in[I_CK] + ((size_t)(b * 2 + kv) * 512 + kt * 64 + key) * 64 + 4 * cc;
              const f32x4 a = *(const f32x4*)kp, c = *(const f32x4*)(kp + 32);
#pragma unroll
              for (int j = 0; j < 4; ++j) { x1[j] = a[j]; x2[j] = c[j]; } }
          else { const bf16* kp = U + (size_t)(rowbase + kt * 64 + key) * NOP + C_KA + kv * 64 + 4 * cc;
              const v2u a = *(const v2u*)kp, c = *(const v2u*)(kp + 32);
              x1[0] = bflo(a.x); x1[1] = bfhi(a.x); x1[2] = bflo(a.y); x1[3] = bfhi(a.y); x2[0] = bflo(c.x); x2[1] = bfhi(c.x); x2[2] = bflo(c.y); x2[3] = bfhi(c.y);
              if (latent) { const int kpos = kt * 64 + key; const float p = (cc < 4) ? (float)(kpos >> 6) : (float)(kpos & 63);
#pragma unroll
                  for (int j = 0; j < 4; ++j) { const float f = exp2f(-(float)((4 * cc + j) & 15) * (13.287712379549449f / 16.f)); float sn, cs; sincosf(p * f, &sn, &cs);
                      const float y1 = x1[j] * cs - x2[j] * sn, y2 = x1[j] * sn + x2[j] * cs; x1[j] = y1; x2[j] = y2; } } }
          v2u w1, w2; w1.x = pk2(x1[0], x1[1]); w1.y = pk2(x1[2], x1[3]); w2.x = pk2(x2[0], x2[1]); w2.y = pk2(x2[2], x2[3]);
          *(LAS v2u*)(lds + AT_K + key * 144 + 8 * cc) = w1; *(LAS v2u*)(lds + AT_K + key * 144 + 64 + 8 * cc) = w2; }
        { const int key = tid & 63, dc = tid >> 6; float v[8];
          if (from_cache) { const float* vp = A.in[I_CV] + ((size_t)(b * 2 + kv) * 512 + kt * 64 + key) * 64 + 8 * dc; const f32x4 a = *(const f32x4*)vp, c = *(const f32x4*)(vp + 4);
#pragma unroll
              for (int j = 0; j < 4; ++j) { v[j] = a[j]; v[4 + j] = c[j]; } }
          else { const v4u a = *(const v4u*)(U + (size_t)(rowbase + kt * 64 + key) * NOP + C_VA + kv * 64 + 8 * dc);
              v[0] = bflo(a.x); v[1] = bfhi(a.x); v[2] = bflo(a.y); v[3] = bfhi(a.y); v[4] = bflo(a.z); v[5] = bfhi(a.z); v[6] = bflo(a.w); v[7] = bfhi(a.w); }
#pragma unroll
          for (int j = 0; j < 8; ++j) *(LAS bf16*)(lds + AT_VT + (8 * dc + j) * 144 + key * 2) = (bf16)f2bf(v[j]); }
        __syncthreads();
        f32x4 S[4]; float tmax = -INFINITY;
#pragma unroll
        for (int st = 0; st < 4; ++st) { S[st] = (f32x4){0.f, 0.f, 0.f, 0.f};
            const bf16x8 ka0 = *(const LAS bf16x8*)(lds + AT_K + (16 * st + fr) * 144 + 16 * fg), ka1 = *(const LAS bf16x8*)(lds + AT_K + (16 * st + fr) * 144 + 64 + 16 * fg);
            S[st] = MFMA16(ka0, qb0, S[st]); S[st] = MFMA16(ka1, qb1, S[st]);
            if (latent && !from_cache) {
#pragma unroll
                for (int i = 0; i < 4; ++i) { const int kpos = kt * 64 + 16 * st + 4 * fg + i; const int dlt = kpos - qpos; if (dlt > 128 || dlt < -128) S[st][i] = -INFINITY; } }
#pragma unroll
            for (int i = 0; i < 4; ++i) tmax = fmaxf(tmax, S[st][i]); }
        tmax = fmaxf(tmax, __shfl_xor(tmax, 16)); tmax = fmaxf(tmax, __shfl_xor(tmax, 32));
        const float m_new = fmaxf(m_run, tmax); const float alpha = __expf(m_run - m_new); m_run = m_new;
        float psum = 0.f;
#pragma unroll
        for (int st = 0; st < 4; ++st)
#pragma unroll
            for (int i = 0; i < 4; ++i) { const float p = __expf(S[st][i] - m_new); S[st][i] = p; psum += p; }
        l_run = l_run * alpha + psum;
#pragma unroll
        for (int dt = 0; dt < 4; ++dt) O[dt] = O[dt] * alpha;
#pragma unroll
        for (int pr = 0; pr < 2; ++pr) { v2u plo, phi; plo.x = pk2(S[2 * pr][0], S[2 * pr][1]); plo.y = pk2(S[2 * pr][2], S[2 * pr][3]); phi.x = pk2(S[2 * pr + 1][0], S[2 * pr + 1][1]); phi.y = pk2(S[2 * pr + 1][2], S[2 * pr + 1][3]);
            const bf16x8 pb = cat44(plo, phi);
#pragma unroll
            for (int dt = 0; dt < 4; ++dt) { const LAS unsigned char* vp = lds + AT_VT + (16 * dt + fr) * 144;
                const v2u a_lo = *(const LAS v2u*)(vp + (32 * pr + 4 * fg) * 2), a_hi = *(const LAS v2u*)(vp + (32 * pr + 16 + 4 * fg) * 2);
                O[dt] = MFMA16(cat44(a_lo, a_hi), pb, O[dt]); } }
        __syncthreads();
    }
    l_run += __shfl_xor(l_run, 16); l_run += __shfl_xor(l_run, 32);
    l_run += __expf(A.in[I_SINK][hq] - m_run);
    const float inv = 1.f / l_run;
    bf16* op = MIX + (size_t)qrow * D + hq * 64 + 4 * fg;
#pragma unroll
    for (int dt = 0; dt < 4; ++dt) { v2u w; w.x = pk2(O[dt][0] * inv, O[dt][1] * inv); w.y = pk2(O[dt][2] * inv, O[dt][3] * inv); *(v2u*)(op + 16 * dt) = w; }
}

__device__ __forceinline__ void phase_odd_mixer(const Args& A, LAS unsigned char* lds) {
    const int G = gridDim.x;
    constexpr int N_ML = 32, N_MC = 512, N_AL = 128, N_AC = 512, NU = N_ML + N_MC + N_AL + N_AC;
    for (int u = blockIdx.x; u < NU; u += G) {
        int r = u;
        if (r < N_ML) { mlstm_unit(A, lds, 1, r >> 4, (r >> 1) & 7, r & 1); }
        else if ((r -= N_ML) < N_MC) { mlstm_unit(A, lds, 0, r >> 4, (r >> 1) & 7, r & 1); }
        else if ((r -= N_MC) < N_AL) { attn_unit(A, lds, 1, r >> 6, (r >> 3) & 7, r & 7); }
        else { r -= N_AL; attn_unit(A, lds, 0, r >> 4, (r >> 1) & 7, r & 1); }
        __syncthreads();
    }
    const bf16* U = (const bf16*)(A.ws + WS_ACT);
    for (int i = blockIdx.x * NTHR + threadIdx.x; i < MP * 64; i += G * NTHR) {
        const int row = i >> 6, c4 = (i & 63) * 4; const int b = row >> 8, t = row & 255;
        const v2u w = *(const v2u*)(U + (size_t)row * NOP + C_KA + c4);
        const f32x4 o = {bflo(w.x), bfhi(w.x), bflo(w.y), bfhi(w.y)};
        const int isv = c4 >> 7, kvh = (c4 >> 6) & 1, d = c4 & 63;
        *(f32x4*)(A.out + (isv ? O_CV : O_CK) + ((size_t)(b * 2 + kvh) * 256 + t) * 64 + d) = o;
    }
}
__device__ __forceinline__ void phase_readout(const Args& A) {
    const int lane = threadIdx.x & 63, gw = blockIdx.x * NWAVES + (threadIdx.x >> 6), NGW = gridDim.x * NWAVES;
    const bf16* U = (const bf16*)(A.ws + WS_ACT); bf16* MIX = (bf16*)(A.ws + WS_MIX); const float* HD = (const float*)(A.ws + WS_OP);
    for (int row = gw; row < M; row += NGW) {
        const float* h0 = HD + (size_t)row * 512 + 8 * lane; const float* h1 = h0 + (size_t)M * 512;
        f32x4 a0 = *(const f32x4*)h0 + *(const f32x4*)h1, a1 = *(const f32x4*)(h0 + 4) + *(const f32x4*)(h1 + 4);
        float s = (a0.x * a0.x + a0.y * a0.y) + (a0.z * a0.z + a0.w * a0.w) + (a1.x * a1.x + a1.y * a1.y) + (a1.z * a1.z + a1.w * a1.w);
        s += __shfl_xor(s, 1); s += __shfl_xor(s, 2); s += __shfl_xor(s, 4);
        const float rstd = rsqrtf(s * (1.f / 64.f) + EPS);
        const f32x4 g0 = *(const f32x4*)(A.in[I_HNG] + 8 * lane), g1 = *(const f32x4*)(A.in[I_HNG] + 8 * lane + 4);
        const v4u om = *(const v4u*)(U + (size_t)row * NOP + C_OM + 8 * lane);
        a0 = a0 * rstd * g0; a1 = a1 * rstd * g1;
        v4u o; o.x = pk2(a0.x * sigmoidf_(bflo(om.x)), a0.y * sigmoidf_(bfhi(om.x))); o.y = pk2(a0.z * sigmoidf_(bflo(om.y)), a0.w * sigmoidf_(bfhi(om.y)));
        o.z = pk2(a1.x * sigmoidf_(bflo(om.z)), a1.y * sigmoidf_(bfhi(om.z))); o.w = pk2(a1.z * sigmoidf_(bflo(om.w)), a1.w * sigmoidf_(bfhi(om.w)));
        *(v4u*)(MIX + (size_t)row * D + 512 + 8 * lane) = o;
    }
}
#ifndef MK_ONE_LAUNCH
#define MK_ONE_LAUNCH 1
#endif
constexpr int N_PHASES = 17;
__global__ void __launch_bounds__(NTHR, 2) fwd_megakernel(Args args) {
    extern __shared__ __attribute__((aligned(16))) unsigned char lds_raw[];
    LAS unsigned char* lds = (LAS unsigned char*)lds_raw;
    cg::grid_group grid = cg::this_grid();
    unsigned char* ws = args.ws;
    bf16* H = (bf16*)(ws + WS_H); bf16* MIX = (bf16*)(ws + WS_MIX); float* OP = (float*)(ws + WS_OP); bf16* ACT = (bf16*)(ws + WS_ACT);
    const int lo = args.ph_lo, hi = args.ph_hi;
#define IN(k) (lo <= (k) && (k) < hi)
#define SEAM(k) do { if (lo <= (k) && (k) + 1 < hi) grid.sync(); } while (0)
#define GEMM_IN(l) do { const int N = (l) ? NOP : NE; \
        pg8::Gemm g{H, (const bf16*)(ws + ((l) ? WS_WOI : WS_WEI)), M, N, D}; pg8::StaticOrder S; S.init(M, N, (int)gridDim.x, (int)blockIdx.x); \
        pg8::EpiBf16<0> E{ACT, N}; pg8::gemm_phase<pg8::EpiBf16<0>, pg8::StaticOrder, true, true>(lds, g, S, E); } while (0)
#define GEMM_F32(Aptr, Wt, K) do { pg8::Gemm g{(Aptr), (const bf16*)(Wt), M, D, (K)}; pg8::StaticOrder S; S.init(M, D, (int)gridDim.x, (int)blockIdx.x); \
        pg8::EpiF32 E{OP, D}; pg8::gemm_phase<pg8::EpiF32, pg8::StaticOrder, true, true>(lds, g, S, E); } while (0)
#define GEMM_UP(l) do { pg8::Gemm g{H, (const bf16*)(ws + WS_W1 + (size_t)(l) * 8 * MiB), M, FF, D}; pg8::StaticOrder S; S.init(M, FF, (int)gridDim.x, (int)blockIdx.x); \
        pg8::EpiBf16<2> E{ACT, FF}; pg8::gemm_phase<pg8::EpiBf16<2>, pg8::StaticOrder, true, true>(lds, g, S, E); } while (0)
    if (IN(0)) phase_p0(args, lds);
    SEAM(0);
    if (IN(1)) phase_prenorm0(args);
    SEAM(1);
    if (IN(2)) GEMM_IN(0);
    SEAM(2);
    if (IN(3)) phase_even_mixer(args, lds);
    SEAM(3);
    if (IN(4)) GEMM_F32(MIX, ws + WS_WEO, D);
    SEAM(4);
    if (IN(5)) phase_post(args, 0, 0);
    SEAM(5);
    if (IN(6)) GEMM_UP(0);
    SEAM(6);
    if (IN(7)) GEMM_F32(ACT, ws + WS_W2, FF);
    SEAM(7);
    if (IN(8)) phase_post(args, 0, 1);
    SEAM(8);
    if (IN(9)) GEMM_IN(1);
    SEAM(9);
    if (IN(10)) phase_odd_mixer(args, lds);
    SEAM(10);
    if (IN(11)) phase_readout(args);
    SEAM(11);
    if (IN(12)) GEMM_F32(MIX, ws + WS_WOO, D);
    SEAM(12);
    if (IN(13)) phase_post(args, 1, 0);
    SEAM(13);
    if (IN(14)) GEMM_UP(1);
    SEAM(14);
    if (IN(15)) GEMM_F32(ACT, ws + WS_W2 + 8 * MiB, FF);
    SEAM(15);
    if (IN(16)) phase_post(args, 1, 1);
}

extern "C" void kernel_launch(void* const* d_in, const int* in_sizes, int n_in, void* d_out, int out_size, void* d_ws, size_t ws_size, hipStream_t stream) {
    static int grid = 0;
    if (grid == 0) {
        if (n_in != 29 || ws_size < WS_END) { fprintf(stderr, "kernel_launch: unexpected n_in %d / ws %zu\n", n_in, ws_size); grid = -1; return; }
        int dev = 0, cus = 0, per_cu = 0;
        hipGetDevice(&dev); hipDeviceGetAttribute(&cus, hipDeviceAttributeMultiprocessorCount, dev);
        if (hipFuncSetAttribute((const void*)fwd_megakernel, hipFuncAttributeMaxDynamicSharedMemorySize, LDS_BYTES) != hipSuccess) { fprintf(stderr, "kernel_launch: hipFuncSetAttribute failed\n"); grid = -1; return; }
        if (hipOccupancyMaxActiveBlocksPerMultiprocessor(&per_cu, (const void*)fwd_megakernel, NTHR, LDS_BYTES) != hipSuccess || per_cu < 1) { fprintf(stderr, "kernel_launch: occupancy query failed (%d)\n", per_cu); (void)hipGetLastError(); per_cu = 1; }
        if (per_cu > 1) per_cu = 1;
        grid = cus * per_cu;
    }
    if (grid < 0) return;
    Args a{};
    for (int i = 0; i < 29; ++i) a.in[i] = (const float*)d_in[i];
    a.out = (float*)d_out; a.ws = (unsigned char*)d_ws;
#if MK_ONE_LAUNCH
    a.ph_lo = 0; a.ph_hi = N_PHASES;
    void* kargs[] = {&a};
    hipError_t e = hipLaunchCooperativeKernel((const void*)fwd_megakernel, dim3(grid), dim3(NTHR), kargs, LDS_BYTES, stream);
    if (e != hipSuccess) fprintf(stderr, "cooperative launch failed: %s (grid %d)\n", hipGetErrorString(e), grid);
#else
    for (int ph = 0; ph < N_PHASES; ++ph) {
        a.ph_lo = ph; a.ph_hi = ph + 1;
        hipLaunchKernelGGL(fwd_megakernel, dim3(grid), dim3(NTHR), LDS_BYTES, stream, a);
    }
#endif
}
```

```cpp
#define MK_ONE_LAUNCH 1
#include <hip/hip_runtime.h>
#include <hip/hip_cooperative_groups.h>
#include <cstdio>
#include <cstdint>
#include <cmath>
namespace cg = cooperative_groups;
namespace pg8 {
#define PG8_LAS __attribute__((address_space(3)))
typedef unsigned short bf16_t;
typedef short bf16x8 __attribute__((ext_vector_type(8)));
typedef float f32x4 __attribute__((ext_vector_type(4)));
typedef unsigned u32x4 __attribute__((ext_vector_type(4)));
constexpr int BM = 256, BK = 64, HALF = 128, HTB = HALF * BK * 2  , STAGE_BYTES = 8 * HTB, NXCD = 8, WGM = 8;

__host__ __device__ __forceinline__ int lds_byte(int r, int c) { const int st = (r >> 4) * 2 + (c >> 5), rr = r & 15, cc = c & 31, ob = rr * 64 + cc * 2; return st * 1024 + (ob ^ (((ob >> 9) & 1) << 5)); }
__host__ __device__ __forceinline__ void stage_rc(int b, int& R, int& C) { const int st = b / 1024, sb = b % 1024, swz = sb ^ (((sb >> 9) & 1) << 5); R = (st >> 1) * 16 + swz / 64; C = (st & 1) * 32 + (swz % 64) / 2; }
__host__ __device__ __forceinline__ int perm32(int rho) { const int n = rho >> 4, i = rho & 15; return 8 * (i >> 2) + 4 * n + (i & 3); }

struct Unit { int pm, pn; };
struct Gemm { const bf16_t* A; const bf16_t* Bt; int M, N, K; };

struct StaticOrder {
    int nM, nN, nwg, G, c;
    __host__ __device__ void init(int M, int N, int G_, int c_) { nM = M / BM; nN = N / BM; nwg = nM * nN; G = G_; c = c_; }
    __host__ __device__ bool next(int i, Unit& u) const {
        const long L = (long)i * G + c; if (L >= nwg) return false;
        int wgid = (int)L; { const int q = nwg / NXCD, r = nwg % NXCD, xcd = wgid % NXCD, off = wgid / NXCD; wgid = (xcd < r ? xcd * (q + 1) : r * (q + 1) + (xcd - r) * q) + off; }
        const int nig = WGM * nN, gid = wgid / nig, fm = gid * WGM, gsz = (nM - fm) < WGM ? (nM - fm) : WGM;
        u.pm = fm + ((wgid % nig) % gsz); u.pn = (wgid % nig) / gsz; return true;
    }
    __device__ __forceinline__ void a_ready(const Unit&) const {}
    __device__ __forceinline__ void done(const Unit&) const {}
};

__device__ __forceinline__ unsigned cvt_pk_bf16(float lo, float hi) { unsigned r; asm volatile("v_cvt_pk_bf16_f32 %0, %1, %2" : "=v"(r) : "v"(lo), "v"(hi)); return r; }
typedef float f32x2 __attribute__((ext_vector_type(2)));
typedef unsigned u32x2 __attribute__((ext_vector_type(2)));
template <int ACT> struct EpiBf16 {
    static constexpr bool PERM = true, AFTER_DRAIN = false;
    bf16_t* O; int ldc;
    __device__ __forceinline__ void operator()(const f32x4 (&acc)[2][2][4][2], const Unit& u, int wr, int wc, int fr, int fq) const {
        const int row0 = u.pm * BM + wr * 64 + fr; const int col0 = u.pn * BM + wc * 32 + 8 * fq;
#pragma unroll
        for (int ai = 0; ai < 2; ++ai)
#pragma unroll
            for (int m = 0; m < 4; ++m) { bf16_t* rowp = O + (size_t)(row0 + ai * HALF + m * 16) * ldc + col0;
#pragma unroll
                for (int bj = 0; bj < 2; ++bj) { f32x4 v0 = acc[ai][bj][m][0], v1 = acc[ai][bj][m][1];
                    if (ACT == 2) {
#pragma unroll
                        for (int q = 0; q < 4; ++q) { float a = fmaxf(v0[q], 0.f), b = fmaxf(v1[q], 0.f); v0[q] = a * a; v1[q] = b * b; }
                    }
                    u32x4 w; w.x = cvt_pk_bf16(v0[0], v0[1]); w.y = cvt_pk_bf16(v0[2], v0[3]); w.z = cvt_pk_bf16(v1[0], v1[1]); w.w = cvt_pk_bf16(v1[2], v1[3]);
                    *(u32x4*)(rowp + bj * HALF) = w; } }
    }
};
struct EpiF32 {
    static constexpr bool PERM = false, AFTER_DRAIN = false;
    float* O; int ldc;
    __device__ __forceinline__ void operator()(const f32x4 (&acc)[2][2][4][2], const Unit& u, int wr, int wc, int fr, int fq) const {
        const int col0 = u.pn * BM + wc * 32 + 4 * fq;
#pragma unroll
        for (int ai = 0; ai < 2; ++ai)
#pragma unroll
            for (int m = 0; m < 4; ++m) { const int r = ai * HALF + wr * 64 + m * 16 + fr; float* rowp = O + (size_t)(u.pm * BM + r) * ldc + col0;
#pragma unroll
                for (int bj = 0; bj < 2; ++bj)
#pragma unroll
                    for (int n = 0; n < 2; ++n) *(f32x4*)(rowp + bj * HALF + n * 16) = acc[ai][bj][m][n]; }
    }
};
template <class Epi, class Sched, bool ALIGN_EPI = false, bool SP2 = false>
__device__ __forceinline__ void gemm_phase(PG8_LAS unsigned char* lds, const Gemm g, const Sched& S, const Epi& E) {
    const int tid = threadIdx.x, wid = __builtin_amdgcn_readfirstlane(tid >> 6), lane = tid & 63, wr = wid >> 2, wc = wid & 3, fr = lane & 15, fq = lane >> 4;
    const int K = g.K, nt = K / BK;
    unsigned voffA[2], voffB[2];
#pragma unroll
    for (int i = 0; i < 2; ++i) { int R, C; stage_rc(tid * 16 + i * 8192, R, C); const int Rb = Epi::PERM ? ((R & ~31) + perm32(R & 31)) : R;
        voffA[i] = (unsigned)(R * K + C) * 2u; voffB[i] = (unsigned)(Rb * K + C) * 2u; }
    const size_t kstep = (size_t)(BK * 2);
    const size_t hstep = (size_t)HALF * K * 2;
    const size_t tstep = 2 * hstep;
    const unsigned ldsw = (unsigned)wid * 1024u;
    const int aoff = lds_byte(wr * 64 + fr, fq * 8), boff = lds_byte(wc * 32 + fr, fq * 8);
#define PG8_SA(b, h) (((b) * 2 + (h)) * HTB)
#define PG8_SB(b, h) ((4 + (b) * 2 + (h)) * HTB)
#define PG8_STAGE(bufoff, gbase, voff) do { _Pragma("unroll") for (int _i = 0; _i < 2; ++_i) \
        __builtin_amdgcn_global_load_lds((const unsigned*)((const char*)(gbase) + (voff)[_i]), (PG8_LAS unsigned*)(lds + (bufoff) + ldsw + _i * 8192), 16, 0, 0); } while (0)
#define PG8_LDA(dst, b, h) do { _Pragma("unroll") for (int m = 0; m < 4; ++m) _Pragma("unroll") for (int k = 0; k < 2; ++k) dst[m][k] = *(const PG8_LAS bf16x8*)(lds + PG8_SA(b, h) + aoff + m * 2048 + k * 1024); } while (0)
#define PG8_LDB(dst, b, h) do { _Pragma("unroll") for (int n = 0; n < 2; ++n) _Pragma("unroll") for (int k = 0; k < 2; ++k) dst[n][k] = *(const PG8_LAS bf16x8*)(lds + PG8_SB(b, h) + boff + n * 2048 + k * 1024); } while (0)
#define PG8_MMA(ai, bj, At, Bt) do { __builtin_amdgcn_s_setprio(1); _Pragma("unroll") for (int m = 0; m < 4; ++m) _Pragma("unroll") for (int n = 0; n < 2; ++n) _Pragma("unroll") for (int k = 0; k < 2; ++k) \
        acc[ai][bj][m][n] = __builtin_amdgcn_mfma_f32_16x16x32_bf16(Bt[n][k], At[m][k], acc[ai][bj][m][n], 0, 0, 0); __builtin_amdgcn_s_setprio(0); } while (0)
#define PG8_WAIT_V(n) asm volatile("s_waitcnt vmcnt(" #n ")" ::: "memory")
#define PG8_WAIT_L(n) asm volatile("s_waitcnt lgkmcnt(" #n ")" ::: "memory")
#define PG8_BAR __builtin_amdgcn_s_barrier()
#define PG8_SCHED __builtin_amdgcn_sched_barrier(0)
    Unit cur, nxt; int ui = 0;
    if (!S.next(0, cur)) return;
    f32x4 acc[2][2][4][2];
#pragma unroll
    for (int a = 0; a < 2; ++a)
#pragma unroll
        for (int b = 0; b < 2; ++b)
#pragma unroll
            for (int m = 0; m < 4; ++m)
#pragma unroll
                for (int n = 0; n < 2; ++n) acc[a][b][m][n] = (f32x4){0.f, 0.f, 0.f, 0.f};
    bf16x8 At[4][2], B0[2][2], B1[2][2];
    const char* cA = (const char*)g.A + (size_t)cur.pm * tstep; const char* cB = (const char*)g.Bt + (size_t)cur.pn * tstep;
    S.a_ready(cur);
    if constexpr (SP2) {
        PG8_STAGE(PG8_SB(0, 0), cB, voffB); PG8_STAGE(PG8_SB(0, 1), cB + hstep, voffB); PG8_STAGE(PG8_SA(0, 0), cA, voffA); PG8_STAGE(PG8_SA(0, 1), cA + hstep, voffA);
        if (wr == 1) PG8_BAR;
        PG8_WAIT_V(2); PG8_BAR;
        PG8_STAGE(PG8_SB(1, 0), cB + kstep, voffB); PG8_STAGE(PG8_SA(1, 0), cA + kstep, voffA); PG8_STAGE(PG8_SB(1, 1), cB + hstep + kstep, voffB);
        PG8_WAIT_V(6); PG8_BAR;
    } else {
        PG8_STAGE(PG8_SB(0, 0), cB, voffB); PG8_STAGE(PG8_SA(0, 0), cA, voffA); PG8_STAGE(PG8_SB(0, 1), cB + hstep, voffB); PG8_STAGE(PG8_SA(0, 1), cA + hstep, voffA);
        if (wr == 1) PG8_BAR;
        PG8_WAIT_V(4); PG8_BAR;
        PG8_STAGE(PG8_SB(1, 0), cB + kstep, voffB); PG8_STAGE(PG8_SA(1, 0), cA + kstep, voffA); PG8_STAGE(PG8_SB(1, 1), cB + hstep + kstep, voffB);
        PG8_WAIT_V(6); PG8_BAR;
    }
    for (;;) {
        const bool has_next = S.next(ui + 1, nxt);
        const char* nA = has_next ? (const char*)g.A + (size_t)nxt.pm * tstep : cA; const char* nB = has_next ? (const char*)g.Bt + (size_t)nxt.pn * tstep : cB;
        for (int t = 0; t < nt; t += 2) {
            const bool last = (t == nt - 2);
            const char* a1 = cA + (size_t)(t + 1) * kstep;
            const char* a2 = last ? nA : cA + (size_t)(t + 2) * kstep; const char* b2 = last ? nB : cB + (size_t)(t + 2) * kstep;
            const char* a3 = a2 + kstep; const char* b3 = b2 + kstep;
            if (last && has_next) S.a_ready(nxt);
            if constexpr (SP2) {
            PG8_LDB(B0, 0, 0); PG8_LDB(B1, 0, 1); PG8_SCHED; PG8_LDA(At, 0, 0); PG8_STAGE(PG8_SA(1, 1), a1 + hstep, voffA);
            PG8_WAIT_V(8); PG8_WAIT_L(0); PG8_BAR; PG8_MMA(0, 0, At, B0); PG8_MMA(0, 1, At, B1); PG8_BAR; PG8_SCHED;
            PG8_LDA(At, 0, 1); PG8_STAGE(PG8_SB(0, 0), b2, voffB); PG8_STAGE(PG8_SB(0, 1), b2 + hstep, voffB); PG8_STAGE(PG8_SA(0, 0), a2, voffA);
            PG8_WAIT_V(8); PG8_WAIT_L(0); PG8_BAR; PG8_MMA(1, 0, At, B0); PG8_MMA(1, 1, At, B1); PG8_BAR; PG8_SCHED;
            PG8_LDB(B0, 1, 0); PG8_LDB(B1, 1, 1); PG8_SCHED; PG8_LDA(At, 1, 0); PG8_STAGE(PG8_SA(0, 1), a2 + hstep, voffA);
            PG8_WAIT_V(8); PG8_WAIT_L(0); PG8_BAR; PG8_MMA(0, 0, At, B0); PG8_MMA(0, 1, At, B1); PG8_BAR; PG8_SCHED;
            PG8_LDA(At, 1, 1); PG8_STAGE(PG8_SB(1, 0), b3, voffB); PG8_STAGE(PG8_SB(1, 1), b3 + hstep, voffB); PG8_STAGE(PG8_SA(1, 0), a3, voffA);
            PG8_WAIT_V(8); PG8_WAIT_L(0); PG8_BAR; PG8_MMA(1, 0, At, B0); PG8_MMA(1, 1, At, B1); PG8_BAR; PG8_SCHED;
            } else {
            PG8_LDB(B0, 0, 0); PG8_SCHED; PG8_LDA(At, 0, 0); PG8_STAGE(PG8_SA(1, 1), a1 + hstep, voffA);
            PG8_WAIT_L(8); PG8_BAR; PG8_WAIT_L(0); PG8_MMA(0, 0, At, B0); PG8_BAR; PG8_SCHED;
            PG8_LDB(B1, 0, 1); PG8_STAGE(PG8_SB(0, 0), b2, voffB);
            PG8_BAR; PG8_WAIT_L(0); PG8_MMA(0, 1, At, B1); PG8_BAR;
            PG8_LDA(At, 0, 1); PG8_STAGE(PG8_SA(0, 0), a2, voffA);
            PG8_BAR; PG8_WAIT_L(0); PG8_MMA(1, 0, At, B0); PG8_BAR; PG8_SCHED;
            PG8_STAGE(PG8_SB(0, 1), b2 + hstep, voffB);
            PG8_WAIT_V(6); PG8_BAR; PG8_MMA(1, 1, At, B1); PG8_BAR;
            PG8_LDB(B0, 1, 0); PG8_SCHED; PG8_LDA(At, 1, 0); PG8_STAGE(PG8_SA(0, 1), a2 + hstep, voffA);
            PG8_WAIT_L(8); PG8_BAR; PG8_WAIT_L(0); PG8_MMA(0, 0, At, B0); PG8_BAR; PG8_SCHED;
            PG8_LDB(B1, 1, 1); PG8_STAGE(PG8_SB(1, 0), b3, voffB);
            PG8_BAR; PG8_WAIT_L(0); PG8_MMA(0, 1, At, B1); PG8_BAR;
            PG8_LDA(At, 1, 1); PG8_STAGE(PG8_SA(1, 0), a3, voffA);
            PG8_BAR; PG8_WAIT_L(0); PG8_MMA(1, 0, At, B0); PG8_BAR; PG8_SCHED;
            PG8_STAGE(PG8_SB(1, 1), b3 + hstep, voffB);
            PG8_WAIT_V(6); PG8_BAR; PG8_MMA(1, 1, At, B1); PG8_BAR;
            }
        }
        if constexpr (ALIGN_EPI) { if (wr == 0) PG8_BAR; }
        if constexpr (!Epi::AFTER_DRAIN) { E(acc, cur, wr, wc, fr, fq); S.done(cur); }
        if (!has_next) break;
#pragma unroll
        for (int a = 0; a < 2; ++a)
#pragma unroll
            for (int b = 0; b < 2; ++b)
#pragma unroll
                for (int m = 0; m < 4; ++m)
#pragma unroll
                    for (int n = 0; n < 2; ++n) acc[a][b][m][n] = (f32x4){0.f, 0.f, 0.f, 0.f};
        cur = nxt; cA = nA; cB = nB; ++ui;
        if constexpr (ALIGN_EPI) { if (wr == 1) PG8_BAR; }
    }
    PG8_WAIT_V(0);
    if constexpr (!ALIGN_EPI) { if (wr == 0) PG8_BAR; }
    PG8_BAR;
    if constexpr (Epi::AFTER_DRAIN) { E.fused(acc, cur, wr, wc, fr, fq, lds, wid, lane); S.done(cur); }
#undef PG8_SA
#undef PG8_SB
#undef PG8_STAGE
#undef PG8_LDA
#undef PG8_LDB
#undef PG8_MMA
#undef PG8_WAIT_V
#undef PG8_WAIT_L
#undef PG8_BAR
#undef PG8_SCHED
}
}
constexpr int NWAVES = 8, NTHR = 512;
constexpr int D = 1024, FF = 4096, MP = 8192, MS = 2048, M = MP + MS;
constexpr int LP = 256, LS = 1024, NBP = 32, NBS = 2;
constexpr int NE = 2560, NO = 2848, NOP = 3072;
constexpr float EPS = 1e-6f;
constexpr int C_QA = 0, C_KA = 512, C_VA = 640, C_QM = 768, C_KM = 1280, C_VM = 1792, C_OM = 2304, C_G = 2816;
constexpr size_t O_YP = 0, O_YS = 8388608, O_CK = 10485760, O_CV = 11534336, O_CF = 12582912, O_NF = 13631488, O_MF = 13647872,
                 O_CB = 13648128, O_NB = 14696704, O_MB = 14713088;
constexpr size_t MiB = 1u << 20;
constexpr size_t WS_MOD = 1 * MiB;
constexpr size_t WS_WEI = 2 * MiB, WS_WEO = 7 * MiB, WS_WOI = 9 * MiB, WS_WOO = 15 * MiB, WS_W1 = 17 * MiB, WS_W2 = 33 * MiB;
constexpr size_t WS_H = 50 * MiB, WS_MIX = 70 * MiB, WS_OP = 90 * MiB, WS_Y = 130 * MiB, WS_ACT = 170 * MiB, WS_END = 250 * MiB;
constexpr int LDS_BYTES = 147456;

#define LAS __attribute__((address_space(3)))
typedef unsigned short bf16;
typedef unsigned v4u __attribute__((ext_vector_type(4)));
typedef unsigned v2u __attribute__((ext_vector_type(2)));
typedef float f32x4 __attribute__((ext_vector_type(4)));
typedef short bf16x8 __attribute__((ext_vector_type(8)));
typedef short bf16x4 __attribute__((ext_vector_type(4)));
__device__ __forceinline__ unsigned f2bf(float f) { unsigned u = __builtin_bit_cast(unsigned, f); return (u + 0x7fffu + ((u >> 16) & 1u)) >> 16; }
__device__ __forceinline__ unsigned pk2(float lo, float hi) { return f2bf(lo) | (f2bf(hi) << 16); }
__device__ __forceinline__ float bflo(unsigned w) { return __uint_as_float(w << 16); }
__device__ __forceinline__ float bfhi(unsigned w) { return __uint_as_float(w & 0xffff0000u); }
__device__ __forceinline__ float bf2f(bf16 b) { return __uint_as_float((unsigned)b << 16); }
__device__ __forceinline__ float wave_sum(float v) {
#pragma unroll
    for (int o = 1; o < 64; o <<= 1) v += __shfl_xor(v, o);
    return v;
}
__device__ __forceinline__ float sigmoidf_(float x) { return 1.f / (1.f + __expf(-x)); }
__device__ __forceinline__ float siluf_(float x) { return x / (1.f + __expf(-x)); }
#define LDS_WAIT() asm volatile("s_waitcnt lgkmcnt(0)" ::: "memory")

struct Args {
    const float* in[29]; float* out; unsigned char* ws; int ph_lo, ph_hi;
};
enum { I_XP = 0, I_XS, I_C, I_CK, I_CV, I_SCF, I_SNF, I_SMF, I_SCB, I_SNB, I_SMB, I_CCTX, I_MODW, I_MODB, I_NORMG, I_W1, I_W2,
       I_EIW, I_CAW, I_CAB, I_LNG, I_LNB, I_CBW, I_EOW, I_OIW, I_SINK, I_GATEB, I_HNG, I_OOW };

__device__ __forceinline__ void p0_transpose_item(const float* W, int K, int N, bf16* WT, LAS float* scr, int item, int lane) {
    const int nblk = N / 32, kb = item / nblk, nb = item % nblk, k0 = 64 * kb, n0 = 32 * nb;
#pragma unroll 8
    for (int i = 0; i < 32; ++i) { const int kk = 2 * i + (lane >> 5); scr[kk * 33 + (lane & 31)] = W[(size_t)(k0 + kk) * N + n0 + (lane & 31)]; }
    LDS_WAIT(); asm volatile("" ::: "memory");
    const int c = lane & 7;
#pragma unroll
    for (int j = 0; j < 4; ++j) { const int n = (lane >> 3) + 8 * j; const LAS float* s = scr + (8 * c) * 33 + n;
        v4u o; o.x = pk2(s[0 * 33], s[1 * 33]); o.y = pk2(s[2 * 33], s[3 * 33]); o.z = pk2(s[4 * 33], s[5 * 33]); o.w = pk2(s[6 * 33], s[7 * 33]);
        *(v4u*)(WT + (size_t)(n0 + n) * K + k0 + 8 * c) = o; }
    LDS_WAIT(); asm volatile("" ::: "memory");
}

__device__ __forceinline__ void phase_p0(const Args& A, LAS unsigned char* lds) {
    const int tid = threadIdx.x, lane = tid & 63, wave = tid >> 6;
    const int G = gridDim.x, gw = blockIdx.x * NWAVES + wave, NGW = G * NWAVES;
    unsigned char* ws = A.ws;
    LAS float* scr = (LAS float*)(lds + wave * 16384);
    constexpr int IT_EI = 16 * (NE / 32), IT_EO = 16 * 32, IT_OI = 16 * (NO / 32), IT_OO = 16 * 32, IT_1 = 16 * (FF / 32), IT_2 = 64 * 32;
    constexpr int NIT = IT_EI + IT_EO + IT_OI + IT_OO + 2 * IT_1 + 2 * IT_2;
    for (int it = gw; it < NIT; it += NGW) {
        int r = it;
        if (r < IT_EI) { p0_transpose_item(A.in[I_EIW], D, NE, (bf16*)(ws + WS_WEI), scr, r, lane); continue; } r -= IT_EI;
        if (r < IT_EO) { p0_transpose_item(A.in[I_EOW], D, D, (bf16*)(ws + WS_WEO), scr, r, lane); continue; } r -= IT_EO;
        if (r < IT_OI) { p0_transpose_item(A.in[I_OIW], D, NO, (bf16*)(ws + WS_WOI), scr, r, lane); continue; } r -= IT_OI;
        if (r < IT_OO) { p0_transpose_item(A.in[I_OOW], D, D, (bf16*)(ws + WS_WOO), scr, r, lane); continue; } r -= IT_OO;
        if (r < IT_1) { p0_transpose_item(A.in[I_W1], D, FF, (bf16*)(ws + WS_W1), scr, r, lane); continue; } r -= IT_1;
        if (r < IT_1) { p0_transpose_item(A.in[I_W1] + (size_t)D * FF, D, FF, (bf16*)(ws + WS_W1 + 8 * MiB), scr, r, lane); continue; } r -= IT_1;
        if (r < IT_2) { p0_transpose_item(A.in[I_W2], FF, D, (bf16*)(ws + WS_W2), scr, r, lane); continue; } r -= IT_2;
        p0_transpose_item(A.in[I_W2] + (size_t)D * FF, FF, D, (bf16*)(ws + WS_W2 + 8 * MiB), scr, r, lane);
    }
    { v4u z = {0u, 0u, 0u, 0u}; v4u* p = (v4u*)(ws + WS_WOI + (size_t)NO * D * 2); const int n16 = (NOP - NO) * D * 2 / 16;
      for (int i = blockIdx.x * NTHR + tid; i < n16; i += G * NTHR) p[i] = z; }
    __syncthreads();
    LAS float* sc = (LAS float*)lds;
    LAS float* red = (LAS float*)(lds + 16384);
    for (int i = tid; i < 3 * D; i += NTHR) { const int r = i / D, k = i % D; const float c = (r == 0) ? A.in[I_CCTX][k] : A.in[I_C][(r - 1) * D + k]; sc[i] = siluf_(c); }
    __syncthreads();
    float* MOD = (float*)(ws + WS_MOD);
    for (int un = blockIdx.x; un < 2 * 96; un += G) {
        const int l = un / 96, cgp = un % 96, cq = tid & 15, kg = tid >> 4;
        const float* Wp = A.in[I_MODW] + (size_t)l * D * 6144 + (size_t)(kg * 32) * 6144 + cgp * 64 + cq * 4;
        f32x4 a0 = {0.f, 0.f, 0.f, 0.f}, a1 = a0, a2 = a0;
#pragma unroll 8
        for (int k = 0; k < 32; ++k) { const f32x4 w = *(const f32x4*)(Wp + (size_t)k * 6144); const int kk = kg * 32 + k;
            a0 += w * sc[kk]; a1 += w * sc[D + kk]; a2 += w * sc[2 * D + kk]; }
        *(LAS f32x4*)(red + (kg * 3 + 0) * 64 + cq * 4) = a0; *(LAS f32x4*)(red + (kg * 3 + 1) * 64 + cq * 4) = a1; *(LAS f32x4*)(red + (kg * 3 + 2) * 64 + cq * 4) = a2;
        __syncthreads();
        if (tid < 192) { const int r = tid >> 6, c = tid & 63; float s = 0.f;
#pragma unroll 8
            for (int k = 0; k < 32; ++k) s += red[(k * 3 + r) * 64 + c];
            MOD[(size_t)(l * 3 + r) * 6144 + cgp * 64 + c] = s + A.in[I_MODB][l * 6144 + cgp * 64 + c]; }
        __syncthreads();
    }
}

__device__ __forceinline__ int cond_of_row(int row) { return row < MP ? 0 : (row < MP + LS ? 1 : 2); }
__device__ __forceinline__ void norm_mod_store(const f32x4 (&v)[4], const float* g, const float* shift, const float* scale, bf16* hrow, int lane) {
    float s = 0.f;
#pragma unroll
    for (int j = 0; j < 4; ++j) s += (v[j].x * v[j].x + v[j].y * v[j].y) + (v[j].z * v[j].z + v[j].w * v[j].w);
    const float rstd = rsqrtf(wave_sum(s) * (1.f / D) + EPS);
#pragma unroll
    for (int j = 0; j < 4; ++j) { const int c = 4 * lane + 256 * j;
        const f32x4 gg = *(const f32x4*)(g + c), sh = *(const f32x4*)(shift + c), sl = *(const f32x4*)(scale + c);
        const f32x4 o = (v[j] * rstd) * gg * (sl + 1.f) + sh;
        v2u w; w.x = pk2(o.x, o.y); w.y = pk2(o.z, o.w); *(v2u*)(hrow + c) = w; }
}
__device__ __forceinline__ void phase_prenorm0(const Args& A) {
    const int lane = threadIdx.x & 63, gw = blockIdx.x * NWAVES + (threadIdx.x >> 6), NGW = gridDim.x * NWAVES;
    const float* MOD = (const float*)(A.ws + WS_MOD); bf16* H = (bf16*)(A.ws + WS_H);
    for (int row = gw; row < M; row += NGW) {
        const float* xr = row < MP ? A.in[I_XP] + (size_t)row * D : A.in[I_XS] + (size_t)(row - MP) * D;
        f32x4 v[4];
#pragma unroll
        for (int j = 0; j < 4; ++j) v[j] = *(const f32x4*)(xr + 4 * lane + 256 * j);
        const float* md = MOD + (size_t)cond_of_row(row) * 6144;
        norm_mod_store(v, A.in[I_NORMG], md, md + D, H + (size_t)row * D, lane);
    }
}
__device__ __forceinline__ void phase_post(const Args& A, int l, int which) {
    const int lane = threadIdx.x & 63, gw = blockIdx.x * NWAVES + (threadIdx.x >> 6), NGW = gridDim.x * NWAVES;
    const float* MOD = (const float*)(A.ws + WS_MOD); bf16* H = (bf16*)(A.ws + WS_H);
    const float* OP = (const float*)(A.ws + WS_OP); float* Y = (float*)(A.ws + WS_Y);
    const float* gA = A.in[I_NORMG] + (size_t)(l * 4 + (which == 0 ? 1 : 3)) * D;
    for (int row = gw; row < M; row += NGW) {
        const float* rr; float* yo;
        if (l == 0 && which == 0) rr = row < MP ? A.in[I_XP] + (size_t)row * D : A.in[I_XS] + (size_t)(row - MP) * D; else rr = Y + (size_t)row * D;
        if (l == 1 && which == 1) yo = A.out + (size_t)row * D; else yo = Y + (size_t)row * D;
        const float* md = MOD + (size_t)(l * 3 + cond_of_row(row)) * 6144;
        const float* gate = md + (which == 0 ? 2 * D : 5 * D);
        f32x4 o[4], r[4]; float s = 0.f;
#pragma unroll
        for (int j = 0; j < 4; ++j) { o[j] = *(const f32x4*)(OP + (size_t)row * D + 4 * lane + 256 * j); r[j] = *(const f32x4*)(rr + 4 * lane + 256 * j);
            s += (o[j].x * o[j].x + o[j].y * o[j].y) + (o[j].z * o[j].z + o[j].w * o[j].w); }
        const float rstd = rsqrtf(wave_sum(s) * (1.f / D) + EPS);
#pragma unroll
        for (int j = 0; j < 4; ++j) { const int c = 4 * lane + 256 * j; const f32x4 gg = *(const f32x4*)(gA + c), gt = *(const f32x4*)(gate + c);
            r[j] = r[j] + gt * ((o[j] * rstd) * gg); *(f32x4*)(yo + c) = r[j]; }
        if (which == 0) norm_mod_store(r, A.in[I_NORMG] + (size_t)(l * 4 + 2) * D, md + 3 * D, md + 4 * D, H + (size_t)row * D, lane);
        else if (l == 0) { const float* md1 = MOD + (size_t)(3 + cond_of_row(row)) * 6144; norm_mod_store(r, A.in[I_NORMG] + (size_t)4 * D, md1, md1 + D, H + (size_t)row * D, lane); }
    }
}

__device__ __forceinline__ void phase_even_mixer(const Args& A, LAS unsigned char* lds) {
    const int tid = threadIdx.x, lane = tid & 63, wave = tid >> 6, ch = tid;
    const bf16* U = (const bf16*)(A.ws + WS_ACT); bf16* MIX = (bf16*)(A.ws + WS_MIX);
    LAS float* cv = (LAS float*)lds;
    float w[31];
#pragma unroll
    for (int k = 0; k < 31; ++k) w[k] = A.in[I_CAW][k * 512 + ch];
    const float cbias = A.in[I_CAB][ch];
    const float wb0 = A.in[I_CBW][ch], wb1 = A.in[I_CBW][512 + ch], wb2 = A.in[I_CBW][1024 + ch];
    for (int tile = blockIdx.x; tile < M / 16; tile += gridDim.x) {
        const int t0 = tile * 16;
        int s0, L; if (t0 < MP) { s0 = t0 & ~(LP - 1); L = LP; } else { s0 = MP + ((t0 - MP) & ~(LS - 1)); L = LS; }
        float acc[16];
#pragma unroll
        for (int t = 0; t < 16; ++t) acc[t] = cbias;
#pragma unroll
        for (int r = 0; r < 46; ++r) {
            const int row = t0 - 15 + r; float v = 0.f;
            if (row >= s0 && row < s0 + L) { const bf16* up = U + (size_t)row * NE + ch; v = bf2f(up[0]) * sigmoidf_(bf2f(up[512])); }
#pragma unroll
            for (int t = 0; t < 16; ++t) { const int k = r - t; if (k >= 0 && k <= 30) acc[t] += w[k] * v; }
        }
#pragma unroll
        for (int t = 0; t < 16; ++t) cv[t * 512 + ch] = acc[t];
        {
            float cb[18];
#pragma unroll
            for (int r = 0; r < 18; ++r) { const int row = t0 - 1 + r; float v = 0.f;
                if (row >= s0 && row < s0 + L) { const bf16* up = U + (size_t)row * NE + ch; v = bf2f(up[1536]) * bf2f(up[2048]); } cb[r] = v; }
#pragma unroll
            for (int t = 0; t < 16; ++t) { const float bg = bf2f(U[(size_t)(t0 + t) * NE + 1024 + ch]);
                const float sv = bg * (wb0 * cb[t] + wb1 * cb[t + 1] + wb2 * cb[t + 2]);
                MIX[(size_t)(t0 + t) * D + 512 + ch] = (bf16)f2bf(sv); }
        }
        __syncthreads();
#pragma unroll
        for (int tt = 0; tt < 2; ++tt) { const int t = wave * 2 + tt;
            const f32x4 x0 = *(LAS f32x4*)(cv + t * 512 + lane * 8), x1 = *(LAS f32x4*)(cv + t * 512 + lane * 8 + 4);
            const float mu = wave_sum((x0.x + x0.y) + (x0.z + x0.w) + (x1.x + x1.y) + (x1.z + x1.w)) * (1.f / 512.f);
            const f32x4 d0 = x0 - mu, d1 = x1 - mu;
            const float var = wave_sum((d0.x * d0.x + d0.y * d0.y) + (d0.z * d0.z + d0.w * d0.w) + (d1.x * d1.x + d1.y * d1.y) + (d1.z * d1.z + d1.w * d1.w)) * (1.f / 512.f);
            const float rstd = rsqrtf(var + EPS);
            const f32x4 g0 = *(const f32x4*)(A.in[I_LNG] + lane * 8), g1 = *(const f32x4*)(A.in[I_LNG] + lane * 8 + 4);
            const f32x4 b0 = *(const f32x4*)(A.in[I_LNB] + lane * 8), b1 = *(const f32x4*)(A.in[I_LNB] + lane * 8 + 4);
            const f32x4 y0 = d0 * rstd * g0 + b0, y1 = d1 * rstd * g1 + b1;
            v4u o; o.x = pk2(siluf_(y0.x), siluf_(y0.y)); o.y = pk2(siluf_(y0.z), siluf_(y0.w)); o.z = pk2(siluf_(y1.x), siluf_(y1.y)); o.w = pk2(siluf_(y1.z), siluf_(y1.w));
            *(v4u*)(MIX + (size_t)(t0 + t) * D + lane * 8) = o; }
        __syncthreads();
    }
}
#define MFMA16(a, b, c) __builtin_amdgcn_mfma_f32_16x16x32_bf16((a), (b), (c), 0, 0, 0)
__device__ __forceinline__ bf16x8 cat44(v2u lo, v2u hi) { v4u w; w.x = lo.x; w.y = lo.y; w.z = hi.x; w.w = hi.y; return __builtin_bit_cast(bf16x8, w); }
__device__ __forceinline__ float logsigmoidf_(float x) { return fminf(x, 0.f) - log1pf(__expf(-fabsf(x))); }

constexpr int ML_K = 0, ML_VT = 18432, ML_KT = ML_VT + 21760, ML_CT = ML_KT + 17408, ML_A = ML_CT + 11520, ML_M = ML_A + 512, ML_MT = ML_M + 512,
              ML_E = ML_MT + 512, ML_WI = ML_E + 512, ML_SC = ML_WI + 512, ML_END = ML_SC + 64;
__device__ __forceinline__ void mlstm_unit(const Args& A, LAS unsigned char* lds, int latent, int b, int h, int dir) {
    const int tid = threadIdx.x, lane = tid & 63, wave = __builtin_amdgcn_readfirstlane(tid >> 6), fr = lane & 15, fg = lane >> 4;
    const bf16* U = (const bf16*)(A.ws + WS_ACT); float* HD = (float*)(A.ws + WS_OP) + (size_t)dir * M * 512;
    const int T = latent ? LS : LP, nc = T / 128, rowbase = latent ? MP + b * LS : b * LP;
    LAS float* la = (LAS float*)(lds + ML_A); LAS float* lM = (LAS float*)(lds + ML_M); LAS float* lmt = (LAS float*)(lds + ML_MT);
    LAS float* le = (LAS float*)(lds + ML_E); LAS float* lwi = (LAS float*)(lds + ML_WI); LAS float* lsc = (LAS float*)(lds + ML_SC);
    f32x4 accC[3];
    float m_prev = 0.f;
    if (latent) m_prev = A.in[dir ? I_SMB : I_SMF][b * 8 + h];
#pragma unroll
    for (int k = 0; k < 3; ++k) { accC[k] = (f32x4){0.f, 0.f, 0.f, 0.f}; const int id = wave + 8 * k;
        if (latent && id < 20) { const int dt = id & 3, et = id >> 2; const int e = 16 * et + fr;
            const float* c0 = A.in[dir ? I_SCB : I_SCF] + (size_t)(b * 8 + h) * 4096; const float* n0 = A.in[dir ? I_SNB : I_SNF] + (size_t)(b * 8 + h) * 64;
#pragma unroll
            for (int i = 0; i < 4; ++i) { const int d = 16 * dt + 4 * fg + i; accC[k][i] = (e < 64) ? c0[d * 64 + e] : (e == 64 ? n0[d] : 0.f); } }
    }
    for (int i = tid; i < 16 * 136; i += NTHR) { const int r = i / 136, c = i % 136; *(LAS bf16*)(lds + ML_VT + (64 + r) * 272 + c * 2) = (r == 0) ? (bf16)0x3F80 : (bf16)0; }
#pragma unroll
    for (int k = 0; k < 3; ++k) { const int id = wave + 8 * k;
        if (id < 20) { const int dt = id & 3, et = id >> 2; v2u w; w.x = pk2(accC[k][0], accC[k][1]); w.y = pk2(accC[k][2], accC[k][3]);
            *(LAS v2u*)(lds + ML_CT + (16 * et + fr) * 144 + (16 * dt + 4 * fg) * 2) = w; } }
    const int gi = dir ? 2 : 0;
    const float gb_i = A.in[I_GATEB][gi * 8 + h], gb_f = A.in[I_GATEB][(gi + 1) * 8 + h];

    for (int c = 0; c < nc; ++c) {
        const int ks = tid >> 2, kpart = tid & 3;
        const int krow = rowbase + (dir ? T - 1 - (c * 128 + ks) : c * 128 + ks);
        unsigned kreg[8];
        { const v4u k0 = *(const v4u*)(U + (size_t)krow * NOP + C_KM + h * 64 + 16 * kpart), k1 = *(const v4u*)(U + (size_t)krow * NOP + C_KM + h * 64 + 16 * kpart + 8);
          const unsigned kin[8] = {k0.x, k0.y, k0.z, k0.w, k1.x, k1.y, k1.z, k1.w};
#pragma unroll
          for (int j = 0; j < 8; ++j) kreg[j] = pk2(bflo(kin[j]) * 0.125f, bfhi(kin[j]) * 0.125f);
          v4u o0 = {kreg[0], kreg[1], kreg[2], kreg[3]}, o1 = {kreg[4], kreg[5], kreg[6], kreg[7]};
          *(LAS v4u*)(lds + ML_K + ks * 144 + 32 * kpart) = o0; *(LAS v4u*)(lds + ML_K + ks * 144 + 32 * kpart + 16) = o1; }
        { const int vs = tid & 127, vpart = tid >> 7; const int vrow = rowbase + (dir ? T - 1 - (c * 128 + vs) : c * 128 + vs);
          const v4u v0 = *(const v4u*)(U + (size_t)vrow * NOP + C_VM + h * 64 + 16 * vpart), v1 = *(const v4u*)(U + (size_t)vrow * NOP + C_VM + h * 64 + 16 * vpart + 8);
          const unsigned vin[8] = {v0.x, v0.y, v0.z, v0.w, v1.x, v1.y, v1.z, v1.w};
#pragma unroll
          for (int j = 0; j < 8; ++j) { *(LAS bf16*)(lds + ML_VT + (16 * vpart + 2 * j) * 272 + vs * 2) = (bf16)(vin[j] & 0xffffu);
                                         *(LAS bf16*)(lds + ML_VT + (16 * vpart + 2 * j + 1) * 272 + vs * 2) = (bf16)(vin[j] >> 16); } }
        const int tq = 16 * wave + fr; const int qrow = rowbase + (dir ? T - 1 - (c * 128 + tq) : c * 128 + tq);
        const bf16x8 qb0 = *(const bf16x8*)(U + (size_t)qrow * NOP + C_QM + h * 64 + 8 * fg), qb1 = *(const bf16x8*)(U + (size_t)qrow * NOP + C_QM + h * 64 + 32 + 8 * fg);
        if (wave == 0) {
            float ig[2], lf[2];
#pragma unroll
            for (int q = 0; q < 2; ++q) { const int tau = 2 * lane + q; const int grow = rowbase + (dir ? T - 1 - (c * 128 + tau) : c * 128 + tau);
                ig[q] = bf2f(U[(size_t)grow * NOP + C_G + gi * 8 + h]) + gb_i; lf[q] = logsigmoidf_(bf2f(U[(size_t)grow * NOP + C_G + (gi + 1) * 8 + h]) + gb_f); }
            const float pairsum = lf[0] + lf[1]; float sc = pairsum;
#pragma unroll
            for (int o = 1; o < 64; o <<= 1) { const float t = __shfl_up(sc, o); if (lane >= o) sc += t; }
            const float excl = sc - pairsum; const float bc0 = excl + lf[0], bc1 = excl + pairsum;
            const float a0 = ig[0] - bc0, a1 = ig[1] - bc1; const float pm1 = fmaxf(a0, a1); float pmx = pm1;
#pragma unroll
            for (int o = 1; o < 64; o <<= 1) { const float t = __shfl_up(pmx, o); if (lane >= o) pmx = fmaxf(pmx, t); }
            float pex = __shfl_up(pmx, 1); if (lane == 0) pex = -INFINITY;
            const float p0 = fmaxf(pex, a0), p1 = fmaxf(pex, pm1);
            const float M0 = fmaxf(m_prev, p0), M1 = fmaxf(m_prev, p1);
            const float blast = __shfl(bc1, 63), Mlast = __shfl(M1, 63);
            la[2 * lane] = a0; la[2 * lane + 1] = a1; lM[2 * lane] = M0; lM[2 * lane + 1] = M1; lmt[2 * lane] = bc0 + M0; lmt[2 * lane + 1] = bc1 + M1;
            le[2 * lane] = __expf(a0 - Mlast); le[2 * lane + 1] = __expf(a1 - Mlast); lwi[2 * lane] = __expf(m_prev - M0); lwi[2 * lane + 1] = __expf(m_prev - M1);
            if (lane == 0) lsc[0] = __expf(m_prev - Mlast);
            m_prev = blast + Mlast;
        }
        __syncthreads();
        {
            const float Mt = lM[tq], mtt = lmt[tq], wit = lwi[tq];
            f32x4 accN[5], accI[5];
#pragma unroll
            for (int et = 0; et < 5; ++et) { accN[et] = (f32x4){0.f, 0.f, 0.f, 0.f}; accI[et] = accN[et]; }
            for (int sp = 0; sp <= (wave >> 1); ++sp) {
                f32x4 S[2];
#pragma unroll
                for (int q = 0; q < 2; ++q) { const int st = 2 * sp + q; S[q] = (f32x4){0.f, 0.f, 0.f, 0.f};
                    if (st <= wave) {
                        const bf16x8 ka0 = *(LAS bf16x8*)(lds + ML_K + (16 * st + fr) * 144 + 16 * fg), ka1 = *(LAS bf16x8*)(lds + ML_K + (16 * st + fr) * 144 + 64 + 16 * fg);
                        S[q] = MFMA16(ka0, qb0, S[q]); S[q] = MFMA16(ka1, qb1, S[q]);
                        const f32x4 av = *(LAS f32x4*)(la + 16 * st + 4 * fg);
#pragma unroll
                        for (int i = 0; i < 4; ++i) { const int s = 16 * st + 4 * fg + i; S[q][i] = (s <= tq) ? S[q][i] * __expf(av[i] - Mt) : 0.f; }
                    } }
                v2u plo, phi; plo.x = pk2(S[0][0], S[0][1]); plo.y = pk2(S[0][2], S[0][3]); phi.x = pk2(S[1][0], S[1][1]); phi.y = pk2(S[1][2], S[1][3]);
                const bf16x8 pb = cat44(plo, phi);
#pragma unroll
                for (int et = 0; et < 5; ++et) { const LAS unsigned char* vp = lds + ML_VT + (16 * et + fr) * 272;
                    const v2u a_lo = *(const LAS v2u*)(vp + (32 * sp + 4 * fg) * 2), a_hi = *(const LAS v2u*)(vp + (32 * sp + 16 + 4 * fg) * 2);
                    accN[et] = MFMA16(cat44(a_lo, a_hi), pb, accN[et]); }
            }
#pragma unroll
            for (int et = 0; et < 5; ++et) { const LAS unsigned char* cp = lds + ML_CT + (16 * et + fr) * 144;
                const bf16x8 c0 = *(const LAS bf16x8*)(cp + 16 * fg), c1 = *(const LAS bf16x8*)(cp + 64 + 16 * fg);
                accI[et] = MFMA16(c0, qb0, accI[et]); accI[et] = MFMA16(c1, qb1, accI[et]); }
            float den = accN[4][0] + wit * accI[4][0]; den = __shfl(den, fr);
            const float hd = 1.f / fmaxf(fabsf(den), __expf(-mtt));
            float* hp = HD + (size_t)qrow * 512 + h * 64 + 4 * fg;
#pragma unroll
            for (int et = 0; et < 4; ++et) { f32x4 o = (accN[et] + accI[et] * wit) * hd; *(f32x4*)(hp + 16 * et) = o; }
        }
        { const float es = le[ks];
#pragma unroll
          for (int j = 0; j < 8; ++j) { *(LAS bf16*)(lds + ML_KT + (16 * kpart + 2 * j) * 272 + ks * 2) = (bf16)f2bf(bflo(kreg[j]) * es);
                                         *(LAS bf16*)(lds + ML_KT + (16 * kpart + 2 * j + 1) * 272 + ks * 2) = (bf16)f2bf(bfhi(kreg[j]) * es); } }
        __syncthreads();
        { const float decay = lsc[0];
#pragma unroll
          for (int k = 0; k < 3; ++k) { const int id = wave + 8 * k;
            if (id < 20) { const int dt = id & 3, et = id >> 2; accC[k] = accC[k] * decay;
#pragma unroll
                for (int sk = 0; sk < 4; ++sk) { const bf16x8 ka = *(const LAS bf16x8*)(lds + ML_KT + (16 * dt + fr) * 272 + (32 * sk + 8 * fg) * 2);
                    const bf16x8 vb = *(const LAS bf16x8*)(lds + ML_VT + (16 * et + fr) * 272 + (32 * sk + 8 * fg) * 2); accC[k] = MFMA16(ka, vb, accC[k]); }
                v2u w; w.x = pk2(accC[k][0], accC[k][1]); w.y = pk2(accC[k][2], accC[k][3]);
                *(LAS v2u*)(lds + ML_CT + (16 * et + fr) * 144 + (16 * dt + 4 * fg) * 2) = w; } } }
        __syncthreads();
    }
    if (!latent) {
        float* oc = A.out + (dir ? O_CB : O_CF) + (size_t)(b * 8 + h) * 4096; float* on = A.out + (dir ? O_NB : O_NF) + (size_t)(b * 8 + h) * 64;
#pragma unroll
        for (int k = 0; k < 3; ++k) { const int id = wave + 8 * k;
            if (id < 20) { const int dt = id & 3, et = id >> 2; const int e = 16 * et + fr;
#pragma unroll
                for (int i = 0; i < 4; ++i) { const int d = 16 * dt + 4 * fg + i; if (e < 64) oc[d * 64 + e] = accC[k][i]; else if (e == 64) on[d] = accC[k][i]; } } }
        if (tid == 0) A.out[(dir ? O_MB : O_MF) + b * 8 + h] = m_prev;
    }
}

constexpr int AT_K = 0, AT_VT = 9216, AT_END = 18432;
__device__ __forceinline__ void rope_freqs(float (&f)[8], int base) {
#pragma unroll
    for (int j = 0; j < 8; ++j) f[j] = exp2f(-(float)((base + j) & 15) * (13.287712379549449f / 16.f));
}
__device__ __forceinline__ void attn_unit(const Args& A, LAS unsigned char* lds, int latent, int b, int hq, int qb) {
    const int tid = threadIdx.x, lane = tid & 63, wave = __builtin_amdgcn_readfirstlane(tid >> 6), fr = lane & 15, fg = lane >> 4;
    const bf16* U = (const bf16*)(A.ws + WS_ACT); bf16* MIX = (bf16*)(A.ws + WS_MIX);
    const int kv = hq >> 2, rowbase = latent ? MP + b * LS : b * LP;
    const int qpos = qb * 128 + 16 * wave + fr, qrow = rowbase + qpos;
    bf16x8 qb0, qb1;
    {
        const v4u q0 = *(const v4u*)(U + (size_t)qrow * NOP + C_QA + hq * 64 + 8 * fg), q1 = *(const v4u*)(U + (size_t)qrow * NOP + C_QA + hq * 64 + 32 + 8 * fg);
        const unsigned a[4] = {q0.x, q0.y, q0.z, q0.w}, c[4] = {q1.x, q1.y, q1.z, q1.w};
        float x1[8], x2[8];
#pragma unroll
        for (int j = 0; j < 4; ++j) { x1[2 * j] = bflo(a[j]); x1[2 * j + 1] = bfhi(a[j]); x2[2 * j] = bflo(c[j]); x2[2 * j + 1] = bfhi(c[j]); }
        if (latent) { float fq[8]; rope_freqs(fq, 8 * fg); const float p = (fg < 2) ? (float)(qpos >> 6) : (float)(qpos & 63);
#pragma unroll
            for (int j = 0; j < 8; ++j) { float sn, cs; sincosf(p * fq[j], &sn, &cs); const float y1 = x1[j] * cs - x2[j] * sn, y2 = x1[j] * sn + x2[j] * cs; x1[j] = y1; x2[j] = y2; } }
        v4u o0, o1; o0.x = pk2(x1[0] * 0.125f, x1[1] * 0.125f); o0.y = pk2(x1[2] * 0.125f, x1[3] * 0.125f); o0.z = pk2(x1[4] * 0.125f, x1[5] * 0.125f); o0.w = pk2(x1[6] * 0.125f, x1[7] * 0.125f);
        o1.x = pk2(x2[0] * 0.125f, x2[1] * 0.125f); o1.y = pk2(x2[2] * 0.125f, x2[3] * 0.125f); o1.z = pk2(x2[4] * 0.125f, x2[5] * 0.125f); o1.w = pk2(x2[6] * 0.125f, x2[7] * 0.125f);
        qb0 = __builtin_bit_cast(bf16x8, o0); qb1 = __builtin_bit_cast(bf16x8, o1);
    }
    f32x4 O[4];
#pragma unroll
    for (int dt = 0; dt < 4; ++dt) O[dt] = (f32x4){0.f, 0.f, 0.f, 0.f};
    float m_run = -1e30f, l_run = 0.f;
    const int nctx = latent ? 8 : 0;
    const int lat0 = latent ? (qb > 0 ? (qb - 1) * 2 : 0) : 0, lat1 = latent ? ((qb + 2) * 2 < LS / 64 ? (qb + 2) * 2 : LS / 64) : LP / 64;
    const int ntiles = nctx + (lat1 - lat0);
    for (int ti = 0; ti < ntiles; ++ti) {
        const bool from_cache = ti < nctx; const int kt = from_cache ? ti : lat0 + (ti - nctx);
        { const int key = tid >> 3, cc = tid & 7; float x1[4], x2[4];
          if (from_cache) { const float* kp = A.in[I_CK] + ((size_t)(b * 2 + kv) * 512 + kt * 64 + key) * 64 + 4 * cc;
              const f32x4 a = *(const f32x4*)kp, c = *(const f32x4*)(kp + 32);
#pragma unroll
              for (int j = 0; j < 4; ++j) { x1[j] = a[j]; x2[j] = c[j]; } }
          else { const bf16* kp = U + (size_t)(rowbase + kt * 64 + key) * NOP + C_KA + kv * 64 + 4 * cc;
              const v2u a = *(const v2u*)kp, c = *(const v2u*)(kp + 32);
              x1[0] = bflo(a.x); x1[1] = bfhi(a.x); x1[2] = bflo(a.y); x1[3] = bfhi(a.y); x2[0] = bflo(c.x); x2[1] = bfhi(c.x); x2[2] = bflo(c.y); x2[3] = bfhi(c.y);
              if (latent) { const int kpos = kt * 64 + key; const float p = (cc < 4) ? (float)(kpos >> 6) : (float)(kpos & 63);
#pragma unroll
                  for (int j = 0; j < 4; ++j) { const float f = exp2f(-(float)((4 * cc + j) & 15) * (13.287712379549449f / 16.f)); float sn, cs; sincosf(p * f, &sn, &cs);
                      const float y1 = x1[j] * cs - x2[j] * sn, y2 = x1[j] * sn + x2[j] * cs; x1[j] = y1; x2[j] = y2; } } }
          v2u w1, w2; w1.x = pk2(x1[0], x1[1]); w1.y = pk2(x1[2], x1[3]); w2.x = pk2(x2[0], x2[1]); w2.y = pk2(x2[2], x2[3]);
          *(LAS v2u*)(lds + AT_K + key * 144 + 8 * cc) = w1; *(LAS v2u*)(lds + AT_K + key * 144 + 64 + 8 * cc) = w2; }
        { const int key = tid & 63, dc = tid >> 6; float v[8];
          if (from_cache) { const float* vp = A.in[I_CV] + ((size_t)(b * 2 + kv) * 512 + kt * 64 + key) * 64 + 8 * dc; const f32x4 a = *(const f32x4*)vp, c = *(const f32x4*)(vp + 4);
#pragma unroll
              for (int j = 0; j < 4; ++j) { v[j] = a[j]; v[4 + j] = c[j]; } }
          else { const v4u a = *(const v4u*)(U + (size_t)(rowbase + kt * 64 + key) * NOP + C_VA + kv * 64 + 8 * dc);
              v[0] = bflo(a.x); v[1] = bfhi(a.x); v[2] = bflo(a.y); v[3] = bfhi(a.y); v[4] = bflo(a.z); v[5] = bfhi(a.z); v[6] = bflo(a.w); v[7] = bfhi(a.w); }
#pragma unroll
          for (int j = 0; j < 8; ++j) *(LAS bf16*)(lds + AT_VT + (8 * dc + j) * 144 + key * 2) = (bf16)f2bf(v[j]); }
        __syncthreads();
        f32x4 S[4]; float tmax = -INFINITY;
#pragma unroll
        for (int st = 0; st < 4; ++st) { S[st] = (f32x4){0.f, 0.f, 0.f, 0.f};
            const bf16x8 ka0 = *(const LAS bf16x8*)(lds + AT_K + (16 * st + fr) * 144 + 16 * fg), ka1 = *(const LAS bf16x8*)(lds + AT_K + (16 * st + fr) * 144 + 64 + 16 * fg);
            S[st] = MFMA16(ka0, qb0, S[st]); S[st] = MFMA16(ka1, qb1, S[st]);
            if (latent && !from_cache) {
#pragma unroll
                for (int i = 0; i < 4; ++i) { const int kpos = kt * 64 + 16 * st + 4 * fg + i; const int dlt = kpos - qpos; if (dlt > 128 || dlt < -128) S[st][i] = -INFINITY; } }
#pragma unroll
            for (int i = 0; i < 4; ++i) tmax = fmaxf(tmax, S[st][i]); }
        tmax = fmaxf(tmax, __shfl_xor(tmax, 16)); tmax = fmaxf(tmax, __shfl_xor(tmax, 32));
        const float m_new = fmaxf(m_run, tmax); const float alpha = __expf(m_run - m_new); m_run = m_new;
        float psum = 0.f;
#pragma unroll
        for (int st = 0; st < 4; ++st)
#pragma unroll
            for (int i = 0; i < 4; ++i) { const float p = __expf(S[st][i] - m_new); S[st][i] = p; psum += p; }
        l_run = l_run * alpha + psum;
#pragma unroll
        for (int dt = 0; dt < 4; ++dt) O[dt] = O[dt] * alpha;
#pragma unroll
        for (int pr = 0; pr < 2; ++pr) { v2u plo, phi; plo.x = pk2(S[2 * pr][0], S[2 * pr][1]); plo.y = pk2(S[2 * pr][2], S[2 * pr][3]); phi.x = pk2(S[2 * pr + 1][0], S[2 * pr + 1][1]); phi.y = pk2(S[2 * pr + 1][2], S[2 * pr + 1][3]);
            const bf16x8 pb = cat44(plo, phi);
#pragma unroll
            for (int dt = 0; dt < 4; ++dt) { const LAS unsigned char* vp = lds + AT_VT + (16 * dt + fr) * 144;
                const v2u a_lo = *(const LAS v2u*)(vp + (32 * pr + 4 * fg) * 2), a_hi = *(const LAS v2u*)(vp + (32 * pr + 16 + 4 * fg) * 2);
                O[dt] = MFMA16(cat44(a_lo, a_hi), pb, O[dt]); } }
        __syncthreads();
    }
    l_run += __shfl_xor(l_run, 16); l_run += __shfl_xor(l_run, 32);
    l_run += __expf(A.in[I_SINK][hq] - m_run);
    const float inv = 1.f / l_run;
    bf16* op = MIX + (size_t)qrow * D + hq * 64 + 4 * fg;
#pragma unroll
    for (int dt = 0; dt < 4; ++dt) { v2u w; w.x = pk2(O[dt][0] * inv, O[dt][1] * inv); w.y = pk2(O[dt][2] * inv, O[dt][3] * inv); *(v2u*)(op + 16 * dt) = w; }
}

__device__ __forceinline__ void phase_odd_mixer(const Args& A, LAS unsigned char* lds) {
    const int G = gridDim.x;
    constexpr int N_ML = 32, N_MC = 512, N_AL = 128, N_AC = 512, NU = N_ML + N_MC + N_AL + N_AC;
    for (int u = blockIdx.x; u < NU; u += G) {
        int r = u;
        if (r < N_ML) { mlstm_unit(A, lds, 1, r >> 4, (r >> 1) & 7, r & 1); }
        else if ((r -= N_ML) < N_MC) { mlstm_unit(A, lds, 0, r >> 4, (r >> 1) & 7, r & 1); }
        else if ((r -= N_MC) < N_AL) { attn_unit(A, lds, 1, r >> 6, (r >> 3) & 7, r & 7); }
        else { r -= N_AL; attn_unit(A, lds, 0, r >> 4, (r >> 1) & 7, r & 1); }
        __syncthreads();
    }
    const bf16* U = (const bf16*)(A.ws + WS_ACT);
    for (int i = blockIdx.x * NTHR + threadIdx.x; i < MP * 64; i += G * NTHR) {
        const int row = i >> 6, c4 = (i & 63) * 4; const int b = row >> 8, t = row & 255;
        const v2u w = *(const v2u*)(U + (size_t)row * NOP + C_KA + c4);
        const f32x4 o = {bflo(w.x), bfhi(w.x), bflo(w.y), bfhi(w.y)};
        const int isv = c4 >> 7, kvh = (c4 >> 6) & 1, d = c4 & 63;
        *(f32x4*)(A.out + (isv ? O_CV : O_CK) + ((size_t)(b * 2 + kvh) * 256 + t) * 64 + d) = o;
    }
}
__device__ __forceinline__ void phase_readout(const Args& A) {
    const int lane = threadIdx.x & 63, gw = blockIdx.x * NWAVES + (threadIdx.x >> 6), NGW = gridDim.x * NWAVES;
    const bf16* U = (const bf16*)(A.ws + WS_ACT); bf16* MIX = (bf16*)(A.ws + WS_MIX); const float* HD = (const float*)(A.ws + WS_OP);
    for (int row = gw; row < M; row += NGW) {
        const float* h0 = HD + (size_t)row * 512 + 8 * lane; const float* h1 = h0 + (size_t)M * 512;
        f32x4 a0 = *(const f32x4*)h0 + *(const f32x4*)h1, a1 = *(const f32x4*)(h0 + 4) + *(const f32x4*)(h1 + 4);
        float s = (a0.x * a0.x + a0.y * a0.y) + (a0.z * a0.z + a0.w * a0.w) + (a1.x * a1.x + a1.y * a1.y) + (a1.z * a1.z + a1.w * a1.w);
        s += __shfl_xor(s, 1); s += __shfl_xor(s, 2); s += __shfl_xor(s, 4);
        const float rstd = rsqrtf(s * (1.f / 64.f) + EPS);
        const f32x4 g0 = *(const f32x4*)(A.in[I_HNG] + 8 * lane), g1 = *(const f32x4*)(A.in[I_HNG] + 8 * lane + 4);
        const v4u om = *(const v4u*)(U + (size_t)row * NOP + C_OM + 8 * lane);
        a0 = a0 * rstd * g0; a1 = a1 * rstd * g1;
        v4u o; o.x = pk2(a0.x * sigmoidf_(bflo(om.x)), a0.y * sigmoidf_(bfhi(om.x))); o.y = pk2(a0.z * sigmoidf_(bflo(om.y)), a0.w * sigmoidf_(bfhi(om.y)));
        o.z = pk2(a1.x * sigmoidf_(bflo(om.z)), a1.y * sigmoidf_(bfhi(om.z))); o.w = pk2(a1.z * sigmoidf_(bflo(om.w)), a1.w * sigmoidf_(bfhi(om.w)));
        *(v4u*)(MIX + (size_t)row * D + 512 + 8 * lane) = o;
    }
}
#ifndef MK_ONE_LAUNCH
#define MK_ONE_LAUNCH 1
#endif
constexpr int N_PHASES = 17;
constexpr int LDS_ST_OFF = 131072 + 320;
#define XB_TMO      128
#define XB_XCNT(j)  (256  + 64 * (j))
#define XB_XSUB(j)  (1280 + 64 * (j))
#define XB_XGEN(j)  (2304 + 64 * (j))
#define XB_TOP      3328
#define XB_TOPGEN   3392
#define XCD_BAR_WORDS 3456
#define XB_SPIN_CAP (1u << 18)

__device__ __forceinline__ unsigned xb_ld(unsigned* p)              { return __hip_atomic_load(p, __ATOMIC_RELAXED, __HIP_MEMORY_SCOPE_AGENT); }
__device__ __forceinline__ unsigned xb_add(unsigned* p, unsigned v) { return __hip_atomic_fetch_add(p, v, __ATOMIC_RELAXED, __HIP_MEMORY_SCOPE_AGENT); }
__device__ __forceinline__ unsigned xb_xcc_id() { return (unsigned)__builtin_amdgcn_s_getreg((3 << 11) | 20) & 0xFu; }
#define XB_SPIN(cond, bar) do { unsigned _sp = 0; while (cond) { __builtin_amdgcn_s_sleep(1); \
    if ((++_sp & 255u) == 0u) { if (xb_ld(&(bar)[XB_TMO])) break; if (_sp > XB_SPIN_CAP) { atomicAdd(&(bar)[XB_TMO], 1u); break; } } } } while (0)

struct XcdBarrier {
    unsigned* bar; unsigned x;
    volatile LAS unsigned* st;
};

__device__ __forceinline__ XcdBarrier xcd_barrier_post(unsigned* bar, volatile LAS unsigned* st) {
    XcdBarrier b; b.bar = bar; b.x = xb_xcc_id(); b.st = st;
    if (threadIdx.x == 0) (void)xb_add(&bar[XB_XCNT(b.x)], 1u);
    return b;
}
__device__ __forceinline__ void xcd_barrier_complete(unsigned* bar, unsigned x, unsigned& nloc, unsigned& nx) {
    const unsigned G = gridDim.x * gridDim.y * gridDim.z;
    unsigned sum, cnt, mine, sp = 0u;
    for (;;) {
        sum = 0u; cnt = 0u; mine = 0u;
#pragma unroll
        for (unsigned j = 0; j < 16; ++j) { const unsigned c = xb_ld(&bar[XB_XCNT(j)]); sum += c; cnt += (c > 0u) ? 1u : 0u; mine = (j == x) ? c : mine; }
        if (sum == G) break;
        __builtin_amdgcn_s_sleep(1);
        if ((++sp & 255u) == 0u) { if (xb_ld(&bar[XB_TMO])) break; if (sp > XB_SPIN_CAP) { atomicAdd(&bar[XB_TMO], 1u); break; } }
    }
    nloc = mine > 0u ? mine : 1u; nx = cnt > 0u ? cnt : 1u;
}

__device__ __forceinline__ void xcd_barrier(const XcdBarrier& b) {
    asm volatile("s_waitcnt vmcnt(0)" ::: "memory");
    __syncthreads();
    if (threadIdx.x == 0) {
        unsigned* bar = b.bar;
        __builtin_amdgcn_s_waitcnt(0);
        unsigned nloc = b.st[0], nx = b.st[1];
        if (nloc == 0u) { xcd_barrier_complete(bar, b.x, nloc, nx); b.st[0] = nloc; b.st[1] = nx; }
        const unsigned old = xb_add(&bar[XB_XSUB(b.x)], 1u);
        const unsigned gen = old / nloc;
        if (old + 1u == (gen + 1u) * nloc) {
            __builtin_amdgcn_fence(__ATOMIC_RELEASE, "agent");
            asm volatile("s_waitcnt vmcnt(0)" ::: "memory");
            const unsigned og = xb_add(&bar[XB_TOP], 1u);
            const unsigned tg = og / nx;
            if (og + 1u == (tg + 1u) * nx) xb_add(&bar[XB_TOPGEN], 1u);
            else XB_SPIN(xb_ld(&bar[XB_TOPGEN]) == tg, bar);
            __builtin_amdgcn_fence(__ATOMIC_ACQUIRE, "agent");
            xb_add(&bar[XB_XGEN(b.x)], 1u);
            asm volatile("s_waitcnt vmcnt(0)" ::: "memory");
        } else {
            XB_SPIN(xb_ld(&bar[XB_XGEN(b.x)]) == gen, bar);
            __builtin_amdgcn_fence(__ATOMIC_ACQUIRE, "agent");
            asm volatile("s_waitcnt vmcnt(0)" ::: "memory");
        }
    }
    __syncthreads();
}

__global__ void __launch_bounds__(NTHR, 2) fwd_megakernel(Args args) {
    extern __shared__ __attribute__((aligned(16))) unsigned char lds_raw[];
    LAS unsigned char* lds = (LAS unsigned char*)lds_raw;
    cg::grid_group grid = cg::this_grid();
    if (threadIdx.x < 4) ((LAS unsigned*)(lds + LDS_ST_OFF))[threadIdx.x] = 0u;
    __syncthreads();
    XcdBarrier bar; bar.bar = (unsigned*)args.ws; bar.x = 0; bar.st = nullptr;
    if (args.ph_hi - args.ph_lo > 1) bar = xcd_barrier_post((unsigned*)args.ws, (volatile LAS unsigned*)(lds + LDS_ST_OFF));
    if (args.ph_hi > 1000) grid.sync();
    unsigned char* ws = args.ws;
    bf16* H = (bf16*)(ws + WS_H); bf16* MIX = (bf16*)(ws + WS_MIX); float* OP = (float*)(ws + WS_OP); bf16* ACT = (bf16*)(ws + WS_ACT);
    const int lo = args.ph_lo, hi = args.ph_hi;
#define IN(k) (lo <= (k) && (k) < hi)
#define SEAM(k) do { if (lo <= (k) && (k) + 1 < hi) xcd_barrier(bar); } while (0)
#define GEMM_IN(l) do { const int N = (l) ? NOP : NE; \
        pg8::Gemm g{H, (const bf16*)(ws + ((l) ? WS_WOI : WS_WEI)), M, N, D}; pg8::StaticOrder S; S.init(M, N, (int)gridDim.x, (int)blockIdx.x); \
        pg8::EpiBf16<0> E{ACT, N}; pg8::gemm_phase<pg8::EpiBf16<0>, pg8::StaticOrder, true, true>(lds, g, S, E); } while (0)
#define GEMM_F32(Aptr, Wt, K) do { pg8::Gemm g{(Aptr), (const bf16*)(Wt), M, D, (K)}; pg8::StaticOrder S; S.init(M, D, (int)gridDim.x, (int)blockIdx.x); \
        pg8::EpiF32 E{OP, D}; pg8::gemm_phase<pg8::EpiF32, pg8::StaticOrder, true, true>(lds, g, S, E); } while (0)
#define GEMM_UP(l) do { pg8::Gemm g{H, (const bf16*)(ws + WS_W1 + (size_t)(l) * 8 * MiB), M, FF, D}; pg8::StaticOrder S; S.init(M, FF, (int)gridDim.x, (int)blockIdx.x); \
        pg8::EpiBf16<2> E{ACT, FF}; pg8::gemm_phase<pg8::EpiBf16<2>, pg8::StaticOrder, true, true>(lds, g, S, E); } while (0)
    if (IN(0)) phase_p0(args, lds);
    SEAM(0);
    if (IN(1)) phase_prenorm0(args);
    SEAM(1);
    if (IN(2)) GEMM_IN(0);
    SEAM(2);
    if (IN(3)) phase_even_mixer(args, lds);
    SEAM(3);
    if (IN(4)) GEMM_F32(MIX, ws + WS_WEO, D);
    SEAM(4);
    if (IN(5)) phase_post(args, 0, 0);
    SEAM(5);
    if (IN(6)) GEMM_UP(0);
    SEAM(6);
    if (IN(7)) GEMM_F32(ACT, ws + WS_W2, FF);
    SEAM(7);
    if (IN(8)) phase_post(args, 0, 1);
    SEAM(8);
    if (IN(9)) GEMM_IN(1);
    SEAM(9);
    if (IN(10)) phase_odd_mixer(args, lds);
    SEAM(10);
    if (IN(11)) phase_readout(args);
    SEAM(11);
    if (IN(12)) GEMM_F32(MIX, ws + WS_WOO, D);
    SEAM(12);
    if (IN(13)) phase_post(args, 1, 0);
    SEAM(13);
    if (IN(14)) GEMM_UP(1);
    SEAM(14);
    if (IN(15)) GEMM_F32(ACT, ws + WS_W2 + 8 * MiB, FF);
    SEAM(15);
    if (IN(16)) phase_post(args, 1, 1);
}

extern "C" void kernel_launch(void* const* d_in, const int* in_sizes, int n_in, void* d_out, int out_size, void* d_ws, size_t ws_size, hipStream_t stream) {
    static int grid = 0;
    if (grid == 0) {
        if (n_in != 29 || ws_size < WS_END) { fprintf(stderr, "kernel_launch: unexpected n_in %d / ws %zu\n", n_in, ws_size); grid = -1; return; }
        int dev = 0, cus = 0, per_cu = 0;
        hipGetDevice(&dev); hipDeviceGetAttribute(&cus, hipDeviceAttributeMultiprocessorCount, dev);
        if (hipFuncSetAttribute((const void*)fwd_megakernel, hipFuncAttributeMaxDynamicSharedMemorySize, LDS_BYTES) != hipSuccess) { fprintf(stderr, "kernel_launch: hipFuncSetAttribute failed\n"); grid = -1; return; }
        if (hipOccupancyMaxActiveBlocksPerMultiprocessor(&per_cu, (const void*)fwd_megakernel, NTHR, LDS_BYTES) != hipSuccess || per_cu < 1) { fprintf(stderr, "kernel_launch: occupancy query failed (%d)\n", per_cu); (void)hipGetLastError(); per_cu = 1; }
        if (per_cu > 1) per_cu = 1;
        grid = cus * per_cu;
    }
    if (grid < 0) return;
    if (hipMemsetAsync(d_ws, 0, 16384, stream) != hipSuccess) { fprintf(stderr, "kernel_launch: memset failed\n"); return; }
    Args a{};
    for (int i = 0; i < 29; ++i) a.in[i] = (const float*)d_in[i];
    a.out = (float*)d_out; a.ws = (unsigned char*)d_ws;
#if MK_ONE_LAUNCH
    a.ph_lo = 0; a.ph_hi = N_PHASES;
    void* kargs[] = {&a};
    hipError_t e = hipLaunchCooperativeKernel((const void*)fwd_megakernel, dim3(grid), dim3(NTHR), kargs, LDS_BYTES, stream);
    if (e != hipSuccess) fprintf(stderr, "cooperative launch failed: %s (grid %d)\n", hipGetErrorString(e), grid);
#else
    for (int ph = 0; ph < N_PHASES; ++ph) {
        a.ph_lo = ph; a.ph_hi = ph + 1;
        hipLaunchKernelGGL(fwd_megakernel, dim3(grid), dim3(NTHR), LDS_BYTES, stream, a);
    }
#endif
}
```

```cpp
#define MK_ONE_LAUNCH 1
#include <hip/hip_runtime.h>
#include <hip/hip_cooperative_groups.h>
#include <cstdio>
#include <cstdint>
#include <cmath>
namespace cg = cooperative_groups;
namespace pg8 {
#define PG8_LAS __attribute__((address_space(3)))
typedef unsigned short bf16_t;
typedef short bf16x8 __attribute__((ext_vector_type(8)));
typedef float f32x4 __attribute__((ext_vector_type(4)));
typedef unsigned u32x4 __attribute__((ext_vector_type(4)));
constexpr int BM = 256, BK = 64, HALF = 128, HTB = HALF * BK * 2  , STAGE_BYTES = 8 * HTB, NXCD = 8, WGM = 8;

__host__ __device__ __forceinline__ int lds_byte(int r, int c) { const int st = (r >> 4) * 2 + (c >> 5), rr = r & 15, cc = c & 31, ob = rr * 64 + cc * 2; return st * 1024 + (ob ^ (((ob >> 9) & 1) << 5)); }
__host__ __device__ __forceinline__ void stage_rc(int b, int& R, int& C) { const int st = b / 1024, sb = b % 1024, swz = sb ^ (((sb >> 9) & 1) << 5); R = (st >> 1) * 16 + swz / 64; C = (st & 1) * 32 + (swz % 64) / 2; }
__host__ __device__ __forceinline__ int perm32(int rho) { const int n = rho >> 4, i = rho & 15; return 8 * (i >> 2) + 4 * n + (i & 3); }

struct Unit { int pm, pn; };
struct Gemm { const bf16_t* A; const bf16_t* Bt; int M, N, K; };

struct StaticOrder {
    int nM, nN, nwg, G, c;
    __host__ __device__ void init(int M, int N, int G_, int c_) { nM = M / BM; nN = N / BM; nwg = nM * nN; G = G_; c = c_; }
    __host__ __device__ bool next(int i, Unit& u) const {
        const long L = (long)i * G + c; if (L >= nwg) return false;
        int wgid = (int)L; { const int q = nwg / NXCD, r = nwg % NXCD, xcd = wgid % NXCD, off = wgid / NXCD; wgid = (xcd < r ? xcd * (q + 1) : r * (q + 1) + (xcd - r) * q) + off; }
        const int nig = WGM * nN, gid = wgid / nig, fm = gid * WGM, gsz = (nM - fm) < WGM ? (nM - fm) : WGM;
        u.pm = fm + ((wgid % nig) % gsz); u.pn = (wgid % nig) / gsz; return true;
    }
    __device__ __forceinline__ void a_ready(const Unit&) const {}
    __device__ __forceinline__ void done(const Unit&) const {}
};

__device__ __forceinline__ unsigned cvt_pk_bf16(float lo, float hi) { unsigned r; asm volatile("v_cvt_pk_bf16_f32 %0, %1, %2" : "=v"(r) : "v"(lo), "v"(hi)); return r; }
typedef float f32x2 __attribute__((ext_vector_type(2)));
typedef unsigned u32x2 __attribute__((ext_vector_type(2)));
template <int ACT> struct EpiBf16 {
    static constexpr bool PERM = true, AFTER_DRAIN = false;
    bf16_t* O; int ldc;
    __device__ __forceinline__ void operator()(const f32x4 (&acc)[2][2][4][2], const Unit& u, int wr, int wc, int fr, int fq) const {
        const int row0 = u.pm * BM + wr * 64 + fr; const int col0 = u.pn * BM + wc * 32 + 8 * fq;
#pragma unroll
        for (int ai = 0; ai < 2; ++ai)
#pragma unroll
            for (int m = 0; m < 4; ++m) { bf16_t* rowp = O + (size_t)(row0 + ai * HALF + m * 16) * ldc + col0;
#pragma unroll
                for (int bj = 0; bj < 2; ++bj) { f32x4 v0 = acc[ai][bj][m][0], v1 = acc[ai][bj][m][1];
                    if (ACT == 2) {
#pragma unroll
                        for (int q = 0; q < 4; ++q) { float a = fmaxf(v0[q], 0.f), b = fmaxf(v1[q], 0.f); v0[q] = a * a; v1[q] = b * b; }
                    }
                    u32x4 w; w.x = cvt_pk_bf16(v0[0], v0[1]); w.y = cvt_pk_bf16(v0[2], v0[3]); w.z = cvt_pk_bf16(v1[0], v1[1]); w.w = cvt_pk_bf16(v1[2], v1[3]);
                    *(u32x4*)(rowp + bj * HALF) = w; } }
    }
};
struct EpiF32 {
    static constexpr bool PERM = false, AFTER_DRAIN = false;
    float* O; int ldc;
    __device__ __forceinline__ void operator()(const f32x4 (&acc)[2][2][4][2], const Unit& u, int wr, int wc, int fr, int fq) const {
        const int col0 = u.pn * BM + wc * 32 + 4 * fq;
#pragma unroll
        for (int ai = 0; ai < 2; ++ai)
#pragma unroll
            for (int m = 0; m < 4; ++m) { const int r = ai * HALF + wr * 64 + m * 16 + fr; float* rowp = O + (size_t)(u.pm * BM + r) * ldc + col0;
#pragma unroll
                for (int bj = 0; bj < 2; ++bj)
#pragma unroll
                    for (int n = 0; n < 2; ++n) *(f32x4*)(rowp + bj * HALF + n * 16) = acc[ai][bj][m][n]; }
    }
};
template <class Epi, class Sched, bool ALIGN_EPI = false, bool SP2 = false>
__device__ __forceinline__ void gemm_phase(PG8_LAS unsigned char* lds, const Gemm g, const Sched& S, const Epi& E) {
    const int tid = threadIdx.x, wid = __builtin_amdgcn_readfirstlane(tid >> 6), lane = tid & 63, wr = wid >> 2, wc = wid & 3, fr = lane & 15, fq = lane >> 4;
    const int K = g.K, nt = K / BK;
    unsigned voffA[2], voffB[2];
#pragma unroll
    for (int i = 0; i < 2; ++i) { int R, C; stage_rc(tid * 16 + i * 8192, R, C); const int Rb = Epi::PERM ? ((R & ~31) + perm32(R & 31)) : R;
        voffA[i] = (unsigned)(R * K + C) * 2u; voffB[i] = (unsigned)(Rb * K + C) * 2u; }
    const size_t kstep = (size_t)(BK * 2);
    const size_t hstep = (size_t)HALF * K * 2;
    const size_t tstep = 2 * hstep;
    const unsigned ldsw = (unsigned)wid * 1024u;
    const int aoff = lds_byte(wr * 64 + fr, fq * 8), boff = lds_byte(wc * 32 + fr, fq * 8);
#define PG8_SA(b, h) (((b) * 2 + (h)) * HTB)
#define PG8_SB(b, h) ((4 + (b) * 2 + (h)) * HTB)
#define PG8_STAGE(bufoff, gbase, voff) do { _Pragma("unroll") for (int _i = 0; _i < 2; ++_i) \
        __builtin_amdgcn_global_load_lds((const unsigned*)((const char*)(gbase) + (voff)[_i]), (PG8_LAS unsigned*)(lds + (bufoff) + ldsw + _i * 8192), 16, 0, 0); } while (0)
#define PG8_LDA(dst, b, h) do { _Pragma("unroll") for (int m = 0; m < 4; ++m) _Pragma("unroll") for (int k = 0; k < 2; ++k) dst[m][k] = *(const PG8_LAS bf16x8*)(lds + PG8_SA(b, h) + aoff + m * 2048 + k * 1024); } while (0)
#define PG8_LDB(dst, b, h) do { _Pragma("unroll") for (int n = 0; n < 2; ++n) _Pragma("unroll") for (int k = 0; k < 2; ++k) dst[n][k] = *(const PG8_LAS bf16x8*)(lds + PG8_SB(b, h) + boff + n * 2048 + k * 1024); } while (0)
#define PG8_MMA(ai, bj, At, Bt) do { __builtin_amdgcn_s_setprio(1); _Pragma("unroll") for (int m = 0; m < 4; ++m) _Pragma("unroll") for (int n = 0; n < 2; ++n) _Pragma("unroll") for (int k = 0; k < 2; ++k) \
        acc[ai][bj][m][n] = __builtin_amdgcn_mfma_f32_16x16x32_bf16(Bt[n][k], At[m][k], acc[ai][bj][m][n], 0, 0, 0); __builtin_amdgcn_s_setprio(0); } while (0)
#define PG8_WAIT_V(n) asm volatile("s_waitcnt vmcnt(" #n ")" ::: "memory")
#define PG8_WAIT_L(n) asm volatile("s_waitcnt lgkmcnt(" #n ")" ::: "memory")
#define PG8_BAR __builtin_amdgcn_s_barrier()
#define PG8_SCHED __builtin_amdgcn_sched_barrier(0)
    Unit cur, nxt; int ui = 0;
    if (!S.next(0, cur)) return;
    f32x4 acc[2][2][4][2];
#pragma unroll
    for (int a = 0; a < 2; ++a)
#pragma unroll
        for (int b = 0; b < 2; ++b)
#pragma unroll
            for (int m = 0; m < 4; ++m)
#pragma unroll
                for (int n = 0; n < 2; ++n) acc[a][b][m][n] = (f32x4){0.f, 0.f, 0.f, 0.f};
    bf16x8 At[4][2], B0[2][2], B1[2][2];
    const char* cA = (const char*)g.A + (size_t)cur.pm * tstep; const char* cB = (const char*)g.Bt + (size_t)cur.pn * tstep;
    S.a_ready(cur);
    if constexpr (SP2) {
        PG8_STAGE(PG8_SB(0, 0), cB, voffB); PG8_STAGE(PG8_SB(0, 1), cB + hstep, voffB); PG8_STAGE(PG8_SA(0, 0), cA, voffA); PG8_STAGE(PG8_SA(0, 1), cA + hstep, voffA);
        if (wr == 1) PG8_BAR;
        PG8_WAIT_V(2); PG8_BAR;
        PG8_STAGE(PG8_SB(1, 0), cB + kstep, voffB); PG8_STAGE(PG8_SA(1, 0), cA + kstep, voffA); PG8_STAGE(PG8_SB(1, 1), cB + hstep + kstep, voffB);
        PG8_WAIT_V(6); PG8_BAR;
    } else {
        PG8_STAGE(PG8_SB(0, 0), cB, voffB); PG8_STAGE(PG8_SA(0, 0), cA, voffA); PG8_STAGE(PG8_SB(0, 1), cB + hstep, voffB); PG8_STAGE(PG8_SA(0, 1), cA + hstep, voffA);
        if (wr == 1) PG8_BAR;
        PG8_WAIT_V(4); PG8_BAR;
        PG8_STAGE(PG8_SB(1, 0), cB + kstep, voffB); PG8_STAGE(PG8_SA(1, 0), cA + kstep, voffA); PG8_STAGE(PG8_SB(1, 1), cB + hstep + kstep, voffB);
        PG8_WAIT_V(6); PG8_BAR;
    }
    for (;;) {
        const bool has_next = S.next(ui + 1, nxt);
        const char* nA = has_next ? (const char*)g.A + (size_t)nxt.pm * tstep : cA; const char* nB = has_next ? (const char*)g.Bt + (size_t)nxt.pn * tstep : cB;
        for (int t = 0; t < nt; t += 2) {
            const bool last = (t == nt - 2);
            const char* a1 = cA + (size_t)(t + 1) * kstep;
            const char* a2 = last ? nA : cA + (size_t)(t + 2) * kstep; const char* b2 = last ? nB : cB + (size_t)(t + 2) * kstep;
            const char* a3 = a2 + kstep; const char* b3 = b2 + kstep;
            if (last && has_next) S.a_ready(nxt);
            if constexpr (SP2) {
            PG8_LDB(B0, 0, 0); PG8_LDB(B1, 0, 1); PG8_SCHED; PG8_LDA(At, 0, 0); PG8_STAGE(PG8_SA(1, 1), a1 + hstep, voffA);
            PG8_WAIT_V(8); PG8_WAIT_L(0); PG8_BAR; PG8_MMA(0, 0, At, B0); PG8_MMA(0, 1, At, B1); PG8_BAR; PG8_SCHED;
            PG8_LDA(At, 0, 1); PG8_STAGE(PG8_SB(0, 0), b2, voffB); PG8_STAGE(PG8_SB(0, 1), b2 + hstep, voffB); PG8_STAGE(PG8_SA(0, 0), a2, voffA);
            PG8_WAIT_V(8); PG8_WAIT_L(0); PG8_BAR; PG8_MMA(1, 0, At, B0); PG8_MMA(1, 1, At, B1); PG8_BAR; PG8_SCHED;
            PG8_LDB(B0, 1, 0); PG8_LDB(B1, 1, 1); PG8_SCHED; PG8_LDA(At, 1, 0); PG8_STAGE(PG8_SA(0, 1), a2 + hstep, voffA);
            PG8_WAIT_V(8); PG8_WAIT_L(0); PG8_BAR; PG8_MMA(0, 0, At, B0); PG8_MMA(0, 1, At, B1); PG8_BAR; PG8_SCHED;
            PG8_LDA(At, 1, 1); PG8_STAGE(PG8_SB(1, 0), b3, voffB); PG8_STAGE(PG8_SB(1, 1), b3 + hstep, voffB); PG8_STAGE(PG8_SA(1, 0), a3, voffA);
            PG8_WAIT_V(8); PG8_WAIT_L(0); PG8_BAR; PG8_MMA(1, 0, At, B0); PG8_MMA(1, 1, At, B1); PG8_BAR; PG8_SCHED;
            } else {
            PG8_LDB(B0, 0, 0); PG8_SCHED; PG8_LDA(At, 0, 0); PG8_STAGE(PG8_SA(1, 1), a1 + hstep, voffA);
            PG8_WAIT_L(8); PG8_BAR; PG8_WAIT_L(0); PG8_MMA(0, 0, At, B0); PG8_BAR; PG8_SCHED;
            PG8_LDB(B1, 0, 1); PG8_STAGE(PG8_SB(0, 0), b2, voffB);
            PG8_BAR; PG8_WAIT_L(0); PG8_MMA(0, 1, At, B1); PG8_BAR;
            PG8_LDA(At, 0, 1); PG8_STAGE(PG8_SA(0, 0), a2, voffA);
            PG8_BAR; PG8_WAIT_L(0); PG8_MMA(1, 0, At, B0); PG8_BAR; PG8_SCHED;
            PG8_STAGE(PG8_SB(0, 1), b2 + hstep, voffB);
            PG8_WAIT_V(6); PG8_BAR; PG8_MMA(1, 1, At, B1); PG8_BAR;
            PG8_LDB(B0, 1, 0); PG8_SCHED; PG8_LDA(At, 1, 0); PG8_STAGE(PG8_SA(0, 1), a2 + hstep, voffA);
            PG8_WAIT_L(8); PG8_BAR; PG8_WAIT_L(0); PG8_MMA(0, 0, At, B0); PG8_BAR; PG8_SCHED;
            PG8_LDB(B1, 1, 1); PG8_STAGE(PG8_SB(1, 0), b3, voffB);
            PG8_BAR; PG8_WAIT_L(0); PG8_MMA(0, 1, At, B1); PG8_BAR;
            PG8_LDA(At, 1, 1); PG8_STAGE(PG8_SA(1, 0), a3, voffA);
            PG8_BAR; PG8_WAIT_L(0); PG8_MMA(1, 0, At, B0); PG8_BAR; PG8_SCHED;
            PG8_STAGE(PG8_SB(1, 1), b3 + hstep, voffB);
            PG8_WAIT_V(6); PG8_BAR; PG8_MMA(1, 1, At, B1); PG8_BAR;
            }
        }
        if constexpr (ALIGN_EPI) { if (wr == 0) PG8_BAR; }
        if constexpr (!Epi::AFTER_DRAIN) { E(acc, cur, wr, wc, fr, fq); S.done(cur); }
        if (!has_next) break;
#pragma unroll
        for (int a = 0; a < 2; ++a)
#pragma unroll
            for (int b = 0; b < 2; ++b)
#pragma unroll
                for (int m = 0; m < 4; ++m)
#pragma unroll
                    for (int n = 0; n < 2; ++n) acc[a][b][m][n] = (f32x4){0.f, 0.f, 0.f, 0.f};
        cur = nxt; cA = nA; cB = nB; ++ui;
        if constexpr (ALIGN_EPI) { if (wr == 1) PG8_BAR; }
    }
    PG8_WAIT_V(0);
    if constexpr (!ALIGN_EPI) { if (wr == 0) PG8_BAR; }
    PG8_BAR;
    if constexpr (Epi::AFTER_DRAIN) { E.fused(acc, cur, wr, wc, fr, fq, lds, wid, lane); S.done(cur); }
#undef PG8_SA
#undef PG8_SB
#undef PG8_STAGE
#undef PG8_LDA
#undef PG8_LDB
#undef PG8_MMA
#undef PG8_WAIT_V
#undef PG8_WAIT_L
#undef PG8_BAR
#undef PG8_SCHED
}
}
constexpr int NWAVES = 8, NTHR = 512;
constexpr int D = 1024, FF = 4096, MP = 8192, MS = 2048, M = MP + MS;
constexpr int LP = 256, LS = 1024, NBP = 32, NBS = 2;
constexpr int NE = 2560, NO = 2848, NOP = 3072;
constexpr float EPS = 1e-6f;
constexpr int C_QA = 0, C_KA = 512, C_VA = 640, C_QM = 768, C_KM = 1280, C_VM = 1792, C_OM = 2304, C_G = 2816;
constexpr size_t O_YP = 0, O_YS = 8388608, O_CK = 10485760, O_CV = 11534336, O_CF = 12582912, O_NF = 13631488, O_MF = 13647872,
                 O_CB = 13648128, O_NB = 14696704, O_MB = 14713088;
constexpr size_t MiB = 1u << 20;
constexpr size_t WS_MOD = 1 * MiB;
constexpr size_t WS_WEI = 2 * MiB, WS_WEO = 7 * MiB, WS_WOI = 9 * MiB, WS_WOO = 15 * MiB, WS_W1 = 17 * MiB, WS_W2 = 33 * MiB;
constexpr size_t WS_H = 50 * MiB, WS_MIX = 70 * MiB, WS_OP = 90 * MiB, WS_Y = 130 * MiB, WS_ACT = 170 * MiB, WS_END = 250 * MiB;
constexpr int LDS_BYTES = 147456;

#define LAS __attribute__((address_space(3)))
typedef unsigned short bf16;
typedef unsigned v4u __attribute__((ext_vector_type(4)));
typedef unsigned v2u __attribute__((ext_vector_type(2)));
typedef float f32x4 __attribute__((ext_vector_type(4)));
typedef short bf16x8 __attribute__((ext_vector_type(8)));
typedef short bf16x4 __attribute__((ext_vector_type(4)));
__device__ __forceinline__ unsigned f2bf(float f) { unsigned u = __builtin_bit_cast(unsigned, f); return (u + 0x7fffu + ((u >> 16) & 1u)) >> 16; }
__device__ __forceinline__ unsigned pk2(float lo, float hi) { return f2bf(lo) | (f2bf(hi) << 16); }
__device__ __forceinline__ float bflo(unsigned w) { return __uint_as_float(w << 16); }
__device__ __forceinline__ float bfhi(unsigned w) { return __uint_as_float(w & 0xffff0000u); }
__device__ __forceinline__ float bf2f(bf16 b) { return __uint_as_float((unsigned)b << 16); }
__device__ __forceinline__ float wave_sum(float v) {
#pragma unroll
    for (int o = 1; o < 64; o <<= 1) v += __shfl_xor(v, o);
    return v;
}
__device__ __forceinline__ float sigmoidf_(float x) { return 1.f / (1.f + __expf(-x)); }
__device__ __forceinline__ float siluf_(float x) { return x / (1.f + __expf(-x)); }
#define LDS_WAIT() asm volatile("s_waitcnt lgkmcnt(0)" ::: "memory")

struct Args {
    const float* in[29]; float* out; unsigned char* ws; int ph_lo, ph_hi;
};
enum { I_XP = 0, I_XS, I_C, I_CK, I_CV, I_SCF, I_SNF, I_SMF, I_SCB, I_SNB, I_SMB, I_CCTX, I_MODW, I_MODB, I_NORMG, I_W1, I_W2,
       I_EIW, I_CAW, I_CAB, I_LNG, I_LNB, I_CBW, I_EOW, I_OIW, I_SINK, I_GATEB, I_HNG, I_OOW };

__device__ __forceinline__ void p0_transpose_item(const float* W, int K, int N, bf16* WT, LAS float* scr, int item, int lane) {
    const int nblk = N / 32, kb = item / nblk, nb = item % nblk, k0 = 64 * kb, n0 = 32 * nb;
#pragma unroll 8
    for (int i = 0; i < 32; ++i) { const int kk = 2 * i + (lane >> 5); scr[kk * 33 + (lane & 31)] = W[(size_t)(k0 + kk) * N + n0 + (lane & 31)]; }
    LDS_WAIT(); asm volatile("" ::: "memory");
    const int c = lane & 7;
#pragma unroll
    for (int j = 0; j < 4; ++j) { const int n = (lane >> 3) + 8 * j; const LAS float* s = scr + (8 * c) * 33 + n;
        v4u o; o.x = pk2(s[0 * 33], s[1 * 33]); o.y = pk2(s[2 * 33], s[3 * 33]); o.z = pk2(s[4 * 33], s[5 * 33]); o.w = pk2(s[6 * 33], s[7 * 33]);
        *(v4u*)(WT + (size_t)(n0 + n) * K + k0 + 8 * c) = o; }
    LDS_WAIT(); asm volatile("" ::: "memory");
}

__device__ __forceinline__ void phase_p0(const Args& A, LAS unsigned char* lds) {
    const int tid = threadIdx.x, lane = tid & 63, wave = tid >> 6;
    const int G = gridDim.x, gw = blockIdx.x * NWAVES + wave, NGW = G * NWAVES;
    unsigned char* ws = A.ws;
    LAS float* scr = (LAS float*)(lds + wave * 16384);
    constexpr int IT_EI = 16 * (NE / 32), IT_EO = 16 * 32, IT_OI = 16 * (NO / 32), IT_OO = 16 * 32, IT_1 = 16 * (FF / 32), IT_2 = 64 * 32;
    constexpr int NIT = IT_EI + IT_EO + IT_OI + IT_OO + 2 * IT_1 + 2 * IT_2;
    for (int it = gw; it < NIT; it += NGW) {
        int r = it;
        if (r < IT_EI) { p0_transpose_item(A.in[I_EIW], D, NE, (bf16*)(ws + WS_WEI), scr, r, lane); continue; } r -= IT_EI;
        if (r < IT_EO) { p0_transpose_item(A.in[I_EOW], D, D, (bf16*)(ws + WS_WEO), scr, r, lane); continue; } r -= IT_EO;
        if (r < IT_OI) { p0_transpose_item(A.in[I_OIW], D, NO, (bf16*)(ws + WS_WOI), scr, r, lane); continue; } r -= IT_OI;
        if (r < IT_OO) { p0_transpose_item(A.in[I_OOW], D, D, (bf16*)(ws + WS_WOO), scr, r, lane); continue; } r -= IT_OO;
        if (r < IT_1) { p0_transpose_item(A.in[I_W1], D, FF, (bf16*)(ws + WS_W1), scr, r, lane); continue; } r -= IT_1;
        if (r < IT_1) { p0_transpose_item(A.in[I_W1] + (size_t)D * FF, D, FF, (bf16*)(ws + WS_W1 + 8 * MiB), scr, r, lane); continue; } r -= IT_1;
        if (r < IT_2) { p0_transpose_item(A.in[I_W2], FF, D, (bf16*)(ws + WS_W2), scr, r, lane); continue; } r -= IT_2;
        p0_transpose_item(A.in[I_W2] + (size_t)D * FF, FF, D, (bf16*)(ws + WS_W2 + 8 * MiB), scr, r, lane);
    }
    { v4u z = {0u, 0u, 0u, 0u}; v4u* p = (v4u*)(ws + WS_WOI + (size_t)NO * D * 2); const int n16 = (NOP - NO) * D * 2 / 16;
      for (int i = blockIdx.x * NTHR + tid; i < n16; i += G * NTHR) p[i] = z; }
    __syncthreads();
    LAS float* sc = (LAS float*)lds;
    LAS float* red = (LAS float*)(lds + 16384);
    for (int i = tid; i < 3 * D; i += NTHR) { const int r = i / D, k = i % D; const float c = (r == 0) ? A.in[I_CCTX][k] : A.in[I_C][(r - 1) * D + k]; sc[i] = siluf_(c); }
    __syncthreads();
    float* MOD = (float*)(ws + WS_MOD);
    for (int un = blockIdx.x; un < 2 * 96; un += G) {
        const int l = un / 96, cgp = un % 96, cq = tid & 15, kg = tid >> 4;
        const float* Wp = A.in[I_MODW] + (size_t)l * D * 6144 + (size_t)(kg * 32) * 6144 + cgp * 64 + cq * 4;
        f32x4 a0 = {0.f, 0.f, 0.f, 0.f}, a1 = a0, a2 = a0;
#pragma unroll 8
        for (int k = 0; k < 32; ++k) { const f32x4 w = *(const f32x4*)(Wp + (size_t)k * 6144); const int kk = kg * 32 + k;
            a0 += w * sc[kk]; a1 += w * sc[D + kk]; a2 += w * sc[2 * D + kk]; }
        *(LAS f32x4*)(red + (kg * 3 + 0) * 64 + cq * 4) = a0; *(LAS f32x4*)(red + (kg * 3 + 1) * 64 + cq * 4) = a1; *(LAS f32x4*)(red + (kg * 3 + 2) * 64 + cq * 4) = a2;
        __syncthreads();
        if (tid < 192) { const int r = tid >> 6, c = tid & 63; float s = 0.f;
#pragma unroll 8
            for (int k = 0; k < 32; ++k) s += red[(k * 3 + r) * 64 + c];
            MOD[(size_t)(l * 3 + r) * 6144 + cgp * 64 + c] = s + A.in[I_MODB][l * 6144 + cgp * 64 + c]; }
        __syncthreads();
    }
}

__device__ __forceinline__ int cond_of_row(int row) { return row < MP ? 0 : (row < MP + LS ? 1 : 2); }
__device__ __forceinline__ void norm_mod_store(const f32x4 (&v)[4], const float* g, const float* shift, const float* scale, bf16* hrow, int lane) {
    float s = 0.f;
#pragma unroll
    for (int j = 0; j < 4; ++j) s += (v[j].x * v[j].x + v[j].y * v[j].y) + (v[j].z * v[j].z + v[j].w * v[j].w);
    const float rstd = rsqrtf(wave_sum(s) * (1.f / D) + EPS);
#pragma unroll
    for (int j = 0; j < 4; ++j) { const int c = 4 * lane + 256 * j;
        const f32x4 gg = *(const f32x4*)(g + c), sh = *(const f32x4*)(shift + c), sl = *(const f32x4*)(scale + c);
        const f32x4 o = (v[j] * rstd) * gg * (sl + 1.f) + sh;
        v2u w; w.x = pk2(o.x, o.y); w.y = pk2(o.z, o.w); *(v2u*)(hrow + c) = w; }
}
__device__ __forceinline__ void phase_prenorm0(const Args& A) {
    const int lane = threadIdx.x & 63, gw = blockIdx.x * NWAVES + (threadIdx.x >> 6), NGW = gridDim.x * NWAVES;
    const float* MOD = (const float*)(A.ws + WS_MOD); bf16* H = (bf16*)(A.ws + WS_H);
    for (int row = gw; row < M; row += NGW) {
        const float* xr = row < MP ? A.in[I_XP] + (size_t)row * D : A.in[I_XS] + (size_t)(row - MP) * D;
        f32x4 v[4];
#pragma unroll
        for (int j = 0; j < 4; ++j) v[j] = *(const f32x4*)(xr + 4 * lane + 256 * j);
        const float* md = MOD + (size_t)cond_of_row(row) * 6144;
        norm_mod_store(v, A.in[I_NORMG], md, md + D, H + (size_t)row * D, lane);
    }
}
__device__ __forceinline__ void phase_post(const Args& A, int l, int which) {
    const int lane = threadIdx.x & 63, gw = blockIdx.x * NWAVES + (threadIdx.x >> 6), NGW = gridDim.x * NWAVES;
    const float* MOD = (const float*)(A.ws + WS_MOD); bf16* H = (bf16*)(A.ws + WS_H);
    const float* OP = (const float*)(A.ws + WS_OP); float* Y = (float*)(A.ws + WS_Y);
    const float* gA = A.in[I_NORMG] + (size_t)(l * 4 + (which == 0 ? 1 : 3)) * D;
    for (int row = gw; row < M; row += NGW) {
        const float* rr; float* yo;
        if (l == 0 && which == 0) rr = row < MP ? A.in[I_XP] + (size_t)row * D : A.in[I_XS] + (size_t)(row - MP) * D; else rr = Y + (size_t)row * D;
        if (l == 1 && which == 1) yo = A.out + (size_t)row * D; else yo = Y + (size_t)row * D;
        const float* md = MOD + (size_t)(l * 3 + cond_of_row(row)) * 6144;
        const float* gate = md + (which == 0 ? 2 * D : 5 * D);
        f32x4 o[4], r[4]; float s = 0.f;
#pragma unroll
        for (int j = 0; j < 4; ++j) { o[j] = *(const f32x4*)(OP + (size_t)row * D + 4 * lane + 256 * j); r[j] = *(const f32x4*)(rr + 4 * lane + 256 * j);
            s += (o[j].x * o[j].x + o[j].y * o[j].y) + (o[j].z * o[j].z + o[j].w * o[j].w); }
        const float rstd = rsqrtf(wave_sum(s) * (1.f / D) + EPS);
#pragma unroll
        for (int j = 0; j < 4; ++j) { const int c = 4 * lane + 256 * j; const f32x4 gg = *(const f32x4*)(gA + c), gt = *(const f32x4*)(gate + c);
            r[j] = r[j] + gt * ((o[j] * rstd) * gg); *(f32x4*)(yo + c) = r[j]; }
        if (which == 0) norm_mod_store(r, A.in[I_NORMG] + (size_t)(l * 4 + 2) * D, md + 3 * D, md + 4 * D, H + (size_t)row * D, lane);
        else if (l == 0) { const float* md1 = MOD + (size_t)(3 + cond_of_row(row)) * 6144; norm_mod_store(r, A.in[I_NORMG] + (size_t)4 * D, md1, md1 + D, H + (size_t)row * D, lane); }
    }
}

__device__ __forceinline__ void phase_even_mixer(const Args& A, LAS unsigned char* lds) {
    const int tid = threadIdx.x, lane = tid & 63, wave = tid >> 6, ch = tid;
    const bf16* U = (const bf16*)(A.ws + WS_ACT); bf16* MIX = (bf16*)(A.ws + WS_MIX);
    LAS float* glu = (LAS float*)lds; LAS float* cv = (LAS float*)(lds + 46 * 2048);
    float w[31];
#pragma unroll
    for (int k = 0; k < 31; ++k) w[k] = A.in[I_CAW][k * 512 + ch];
    const float cbias = A.in[I_CAB][ch];
    for (int tile = blockIdx.x; tile < M / 16; tile += gridDim.x) {
        const int t0 = tile * 16;
        int s0, L; if (t0 < MP) { s0 = t0 & ~(LP - 1); L = LP; } else { s0 = MP + ((t0 - MP) & ~(LS - 1)); L = LS; }
        for (int i = tid; i < 46 * 64; i += NTHR) { const int r = i >> 6, g8 = i & 63, row = t0 - 15 + r;
            f32x4 o0 = {0.f, 0.f, 0.f, 0.f}, o1 = o0;
            if (row >= s0 && row < s0 + L) { const v4u av = *(const v4u*)(U + (size_t)row * NE + 8 * g8), ag = *(const v4u*)(U + (size_t)row * NE + 512 + 8 * g8);
                o0.x = bflo(av.x) * sigmoidf_(bflo(ag.x)); o0.y = bfhi(av.x) * sigmoidf_(bfhi(ag.x)); o0.z = bflo(av.y) * sigmoidf_(bflo(ag.y)); o0.w = bfhi(av.y) * sigmoidf_(bfhi(ag.y));
                o1.x = bflo(av.z) * sigmoidf_(bflo(ag.z)); o1.y = bfhi(av.z) * sigmoidf_(bfhi(ag.z)); o1.z = bflo(av.w) * sigmoidf_(bflo(ag.w)); o1.w = bfhi(av.w) * sigmoidf_(bfhi(ag.w)); }
            *(LAS f32x4*)(glu + r * 512 + 8 * g8) = o0; *(LAS f32x4*)(glu + r * 512 + 8 * g8 + 4) = o1; }
#pragma unroll
        for (int k = 0; k < 2; ++k) { const int i = tid + NTHR * k, t = i >> 6, g8 = i & 63, row = t0 + t;
            float cb[3][8];
#pragma unroll
            for (int q = 0; q < 3; ++q) { const int rr = row - 1 + q;
                if (rr >= s0 && rr < s0 + L) { const v4u cgv = *(const v4u*)(U + (size_t)rr * NE + 1536 + 8 * g8), bx = *(const v4u*)(U + (size_t)rr * NE + 2048 + 8 * g8);
                    cb[q][0] = bflo(cgv.x) * bflo(bx.x); cb[q][1] = bfhi(cgv.x) * bfhi(bx.x); cb[q][2] = bflo(cgv.y) * bflo(bx.y); cb[q][3] = bfhi(cgv.y) * bfhi(bx.y);
                    cb[q][4] = bflo(cgv.z) * bflo(bx.z); cb[q][5] = bfhi(cgv.z) * bfhi(bx.z); cb[q][6] = bflo(cgv.w) * bflo(bx.w); cb[q][7] = bfhi(cgv.w) * bfhi(bx.w); }
                else {
#pragma unroll
                    for (int j = 0; j < 8; ++j) cb[q][j] = 0.f; } }
            const v4u bgv = *(const v4u*)(U + (size_t)row * NE + 1024 + 8 * g8);
            const float bg[8] = {bflo(bgv.x), bfhi(bgv.x), bflo(bgv.y), bfhi(bgv.y), bflo(bgv.z), bfhi(bgv.z), bflo(bgv.w), bfhi(bgv.w)};
            float sv[8];
#pragma unroll
            for (int h = 0; h < 2; ++h) { const f32x4 w0 = *(const f32x4*)(A.in[I_CBW] + 8 * g8 + 4 * h), w1 = *(const f32x4*)(A.in[I_CBW] + 512 + 8 * g8 + 4 * h), w2 = *(const f32x4*)(A.in[I_CBW] + 1024 + 8 * g8 + 4 * h);
#pragma unroll
                for (int j = 0; j < 4; ++j) sv[4 * h + j] = bg[4 * h + j] * (w0[j] * cb[0][4 * h + j] + w1[j] * cb[1][4 * h + j] + w2[j] * cb[2][4 * h + j]); }
            v4u o; o.x = pk2(sv[0], sv[1]); o.y = pk2(sv[2], sv[3]); o.z = pk2(sv[4], sv[5]); o.w = pk2(sv[6], sv[7]);
            *(v4u*)(MIX + (size_t)row * D + 512 + 8 * g8) = o; }
        __syncthreads();
        { float acc[16];
#pragma unroll
          for (int t = 0; t < 16; ++t) acc[t] = cbias;
#pragma unroll
          for (int r = 0; r < 46; ++r) { const float v = glu[r * 512 + ch];
#pragma unroll
              for (int t = 0; t < 16; ++t) { const int k = r - t; if (k >= 0 && k <= 30) acc[t] += w[k] * v; } }
#pragma unroll
          for (int t = 0; t < 16; ++t) cv[t * 512 + ch] = acc[t]; }
        __syncthreads();
#pragma unroll
        for (int tt = 0; tt < 2; ++tt) { const int t = wave * 2 + tt;
            const f32x4 x0 = *(LAS f32x4*)(cv + t * 512 + lane * 8), x1 = *(LAS f32x4*)(cv + t * 512 + lane * 8 + 4);
            const float mu = wave_sum((x0.x + x0.y) + (x0.z + x0.w) + (x1.x + x1.y) + (x1.z + x1.w)) * (1.f / 512.f);
            const f32x4 d0 = x0 - mu, d1 = x1 - mu;
            const float var = wave_sum((d0.x * d0.x + d0.y * d0.y) + (d0.z * d0.z + d0.w * d0.w) + (d1.x * d1.x + d1.y * d1.y) + (d1.z * d1.z + d1.w * d1.w)) * (1.f / 512.f);
            const float rstd = rsqrtf(var + EPS);
            const f32x4 g0 = *(const f32x4*)(A.in[I_LNG] + lane * 8), g1 = *(const f32x4*)(A.in[I_LNG] + lane * 8 + 4);
            const f32x4 b0 = *(const f32x4*)(A.in[I_LNB] + lane * 8), b1 = *(const f32x4*)(A.in[I_LNB] + lane * 8 + 4);
            const f32x4 y0 = d0 * rstd * g0 + b0, y1 = d1 * rstd * g1 + b1;
            v4u o; o.x = pk2(siluf_(y0.x), siluf_(y0.y)); o.y = pk2(siluf_(y0.z), siluf_(y0.w)); o.z = pk2(siluf_(y1.x), siluf_(y1.y)); o.w = pk2(siluf_(y1.z), siluf_(y1.w));
            *(v4u*)(MIX + (size_t)(t0 + t) * D + lane * 8) = o; }
        __syncthreads();
    }
}
#define MFMA16(a, b, c) __builtin_amdgcn_mfma_f32_16x16x32_bf16((a), (b), (c), 0, 0, 0)
__device__ __forceinline__ bf16x8 cat44(v2u lo, v2u hi) { v4u w; w.x = lo.x; w.y = lo.y; w.z = hi.x; w.w = hi.y; return __builtin_bit_cast(bf16x8, w); }
__device__ __forceinline__ float logsigmoidf_(float x) { return fminf(x, 0.f) - log1pf(__expf(-fabsf(x))); }

constexpr int ML_K = 0, ML_VT = 18432, ML_KT = ML_VT + 21760, ML_CT = ML_KT + 17408, ML_A = ML_CT + 11520, ML_PM = ML_A + 4096, ML_BC = ML_PM + 4096, ML_END = ML_BC + 4096;
__device__ __forceinline__ void mlstm_unit(const Args& A, LAS unsigned char* lds, int latent, int b, int h, int dir) {
    const int tid = threadIdx.x, lane = tid & 63, wave = __builtin_amdgcn_readfirstlane(tid >> 6), fr = lane & 15, fg = lane >> 4;
    const bf16* U = (const bf16*)(A.ws + WS_ACT); float* HD = (float*)(A.ws + WS_OP) + (size_t)dir * M * 512;
    const int T = latent ? LS : LP, nc = T / 128, rowbase = latent ? MP + b * LS : b * LP;
    LAS float* la = (LAS float*)(lds + ML_A); LAS float* lpm = (LAS float*)(lds + ML_PM); LAS float* lbc = (LAS float*)(lds + ML_BC);
    f32x4 accC[3];
    float m_prev = 0.f;
    if (latent) m_prev = A.in[dir ? I_SMB : I_SMF][b * 8 + h];
#pragma unroll
    for (int k = 0; k < 3; ++k) { accC[k] = (f32x4){0.f, 0.f, 0.f, 0.f}; const int id = wave + 8 * k;
        if (latent && id < 20) { const int dt = id & 3, et = id >> 2; const int e = 16 * et + fr;
            const float* c0 = A.in[dir ? I_SCB : I_SCF] + (size_t)(b * 8 + h) * 4096; const float* n0 = A.in[dir ? I_SNB : I_SNF] + (size_t)(b * 8 + h) * 64;
#pragma unroll
            for (int i = 0; i < 4; ++i) { const int d = 16 * dt + 4 * fg + i; accC[k][i] = (e < 64) ? c0[d * 64 + e] : (e == 64 ? n0[d] : 0.f); } }
    }
    for (int i = tid; i < 16 * 136; i += NTHR) { const int r = i / 136, c = i % 136; *(LAS bf16*)(lds + ML_VT + (64 + r) * 272 + c * 2) = (r == 0) ? (bf16)0x3F80 : (bf16)0; }
#pragma unroll
    for (int k = 0; k < 3; ++k) { const int id = wave + 8 * k;
        if (id < 20) { const int dt = id & 3, et = id >> 2; v2u w; w.x = pk2(accC[k][0], accC[k][1]); w.y = pk2(accC[k][2], accC[k][3]);
            *(LAS v2u*)(lds + ML_CT + (16 * et + fr) * 144 + (16 * dt + 4 * fg) * 2) = w; } }
    const int gi = dir ? 2 : 0;
    const float gb_i = A.in[I_GATEB][gi * 8 + h], gb_f = A.in[I_GATEB][(gi + 1) * 8 + h];

    const int ks = tid >> 2, kpart = tid & 3, vs = tid & 127, vpart = tid >> 7, tq = 16 * wave + fr;
    v4u pk0, pk1, pv0, pv1; bf16x8 pq0, pq1;
#define ML_ROW(c_, tau_) (rowbase + (dir ? T - 1 - ((c_) * 128 + (tau_)) : (c_) * 128 + (tau_)))
#define ML_LOAD(c_) do { \
        const bf16* kp_ = U + (size_t)ML_ROW(c_, ks) * NOP + C_KM + h * 64 + 16 * kpart; pk0 = *(const v4u*)kp_; pk1 = *(const v4u*)(kp_ + 8); \
        const bf16* vp_ = U + (size_t)ML_ROW(c_, vs) * NOP + C_VM + h * 64 + 16 * vpart; pv0 = *(const v4u*)vp_; pv1 = *(const v4u*)(vp_ + 8); \
        const bf16* qp_ = U + (size_t)ML_ROW(c_, tq) * NOP + C_QM + h * 64 + 8 * fg; pq0 = *(const bf16x8*)qp_; pq1 = *(const bf16x8*)(qp_ + 32); \
    } while (0)
    ML_LOAD(0);
    if (wave < nc) {
        float ig[2], lf[2];
#pragma unroll
        for (int q = 0; q < 2; ++q) { const bf16* gp = U + (size_t)ML_ROW(wave, 2 * lane + q) * NOP + C_G + gi * 8 + h; ig[q] = bf2f(gp[0]) + gb_i; lf[q] = logsigmoidf_(bf2f(gp[8]) + gb_f); }
        const float pairsum = lf[0] + lf[1]; float sc = pairsum;
#pragma unroll
        for (int o = 1; o < 64; o <<= 1) { const float t = __shfl_up(sc, o); if (lane >= o) sc += t; }
        const float excl = sc - pairsum; const float bc0 = excl + lf[0], bc1 = excl + pairsum;
        const float a0 = ig[0] - bc0, a1 = ig[1] - bc1; const float pm1 = fmaxf(a0, a1); float pmx = pm1;
#pragma unroll
        for (int o = 1; o < 64; o <<= 1) { const float t = __shfl_up(pmx, o); if (lane >= o) pmx = fmaxf(pmx, t); }
        float pex = __shfl_up(pmx, 1); if (lane == 0) pex = -INFINITY;
        la[wave * 128 + 2 * lane] = a0; la[wave * 128 + 2 * lane + 1] = a1; lpm[wave * 128 + 2 * lane] = fmaxf(pex, a0); lpm[wave * 128 + 2 * lane + 1] = fmaxf(pex, pm1);
        lbc[wave * 128 + 2 * lane] = bc0; lbc[wave * 128 + 2 * lane + 1] = bc1;
    }
    for (int c = 0; c < nc; ++c) {
        unsigned kreg[8];
        { const unsigned kin[8] = {pk0.x, pk0.y, pk0.z, pk0.w, pk1.x, pk1.y, pk1.z, pk1.w};
#pragma unroll
          for (int j = 0; j < 8; ++j) kreg[j] = pk2(bflo(kin[j]) * 0.125f, bfhi(kin[j]) * 0.125f);
          v4u o0 = {kreg[0], kreg[1], kreg[2], kreg[3]}, o1 = {kreg[4], kreg[5], kreg[6], kreg[7]};
          *(LAS v4u*)(lds + ML_K + ks * 144 + 32 * kpart) = o0; *(LAS v4u*)(lds + ML_K + ks * 144 + 32 * kpart + 16) = o1; }
        { const unsigned vin[8] = {pv0.x, pv0.y, pv0.z, pv0.w, pv1.x, pv1.y, pv1.z, pv1.w};
#pragma unroll
          for (int j = 0; j < 8; ++j) { *(LAS bf16*)(lds + ML_VT + (16 * vpart + 2 * j) * 272 + vs * 2) = (bf16)(vin[j] & 0xffffu);
                                         *(LAS bf16*)(lds + ML_VT + (16 * vpart + 2 * j + 1) * 272 + vs * 2) = (bf16)(vin[j] >> 16); } }
        const int qrow = ML_ROW(c, tq);
        const bf16x8 qb0 = pq0, qb1 = pq1;
        __syncthreads();
        if (c + 1 < nc) ML_LOAD(c + 1);
        {
            const float Mt = fmaxf(m_prev, lpm[c * 128 + tq]), mtt = lbc[c * 128 + tq] + Mt, wit = __expf(m_prev - Mt);
            f32x4 accN[5], accI[5];
#pragma unroll
            for (int et = 0; et < 5; ++et) { accN[et] = (f32x4){0.f, 0.f, 0.f, 0.f}; accI[et] = accN[et]; }
            for (int sp = 0; sp <= (wave >> 1); ++sp) {
                f32x4 S[2];
#pragma unroll
                for (int q = 0; q < 2; ++q) { const int st = 2 * sp + q; S[q] = (f32x4){0.f, 0.f, 0.f, 0.f};
                    if (st <= wave) {
                        const bf16x8 ka0 = *(LAS bf16x8*)(lds + ML_K + (16 * st + fr) * 144 + 16 * fg), ka1 = *(LAS bf16x8*)(lds + ML_K + (16 * st + fr) * 144 + 64 + 16 * fg);
                        S[q] = MFMA16(ka0, qb0, S[q]); S[q] = MFMA16(ka1, qb1, S[q]);
                        const f32x4 av = *(LAS f32x4*)(la + c * 128 + 16 * st + 4 * fg);
#pragma unroll
                        for (int i = 0; i < 4; ++i) { const int s = 16 * st + 4 * fg + i; S[q][i] = (s <= tq) ? S[q][i] * __expf(av[i] - Mt) : 0.f; }
                    } }
                v2u plo, phi; plo.x = pk2(S[0][0], S[0][1]); plo.y = pk2(S[0][2], S[0][3]); phi.x = pk2(S[1][0], S[1][1]); phi.y = pk2(S[1][2], S[1][3]);
                const bf16x8 pb = cat44(plo, phi);
#pragma unroll
                for (int et = 0; et < 5; ++et) { const LAS unsigned char* vp = lds + ML_VT + (16 * et + fr) * 272;
                    const v2u a_lo = *(const LAS v2u*)(vp + (32 * sp + 4 * fg) * 2), a_hi = *(const LAS v2u*)(vp + (32 * sp + 16 + 4 * fg) * 2);
                    accN[et] = MFMA16(cat44(a_lo, a_hi), pb, accN[et]); }
            }
#pragma unroll
            for (int et = 0; et < 5; ++et) { const LAS unsigned char* cp = lds + ML_CT + (16 * et + fr) * 144;
                const bf16x8 c0 = *(const LAS bf16x8*)(cp + 16 * fg), c1 = *(const LAS bf16x8*)(cp + 64 + 16 * fg);
                accI[et] = MFMA16(c0, qb0, accI[et]); accI[et] = MFMA16(c1, qb1, accI[et]); }
            float den = accN[4][0] + wit * accI[4][0]; den = __shfl(den, fr);
            const float hd = 1.f / fmaxf(fabsf(den), __expf(-mtt));
            float* hp = HD + (size_t)qrow * 512 + h * 64 + 4 * fg;
#pragma unroll
            for (int et = 0; et < 4; ++et) { f32x4 o = (accN[et] + accI[et] * wit) * hd; *(f32x4*)(hp + 16 * et) = o; }
        }
        const float Mlast = fmaxf(m_prev, lpm[c * 128 + 127]);
        { const float es = __expf(la[c * 128 + ks] - Mlast);
#pragma unroll
          for (int j = 0; j < 8; ++j) { *(LAS bf16*)(lds + ML_KT + (16 * kpart + 2 * j) * 272 + ks * 2) = (bf16)f2bf(bflo(kreg[j]) * es);
                                         *(LAS bf16*)(lds + ML_KT + (16 * kpart + 2 * j + 1) * 272 + ks * 2) = (bf16)f2bf(bfhi(kreg[j]) * es); } }
        __syncthreads();
        { const float decay = __expf(m_prev - Mlast);
#pragma unroll
          for (int k = 0; k < 3; ++k) { const int id = wave + 8 * k;
            if (id < 20) { const int dt = id & 3, et = id >> 2; accC[k] = accC[k] * decay;
#pragma unroll
                for (int sk = 0; sk < 4; ++sk) { const bf16x8 ka = *(const LAS bf16x8*)(lds + ML_KT + (16 * dt + fr) * 272 + (32 * sk + 8 * fg) * 2);
                    const bf16x8 vb = *(const LAS bf16x8*)(lds + ML_VT + (16 * et + fr) * 272 + (32 * sk + 8 * fg) * 2); accC[k] = MFMA16(ka, vb, accC[k]); }
                v2u w; w.x = pk2(accC[k][0], accC[k][1]); w.y = pk2(accC[k][2], accC[k][3]);
                *(LAS v2u*)(lds + ML_CT + (16 * et + fr) * 144 + (16 * dt + 4 * fg) * 2) = w; } } }
        m_prev = lbc[c * 128 + 127] + Mlast;
        __syncthreads();
    }
    if (!latent) {
        float* oc = A.out + (dir ? O_CB : O_CF) + (size_t)(b * 8 + h) * 4096; float* on = A.out + (dir ? O_NB : O_NF) + (size_t)(b * 8 + h) * 64;
#pragma unroll
        for (int k = 0; k < 3; ++k) { const int id = wave + 8 * k;
            if (id < 20) { const int dt = id & 3, et = id >> 2; const int e = 16 * et + fr;
#pragma unroll
                for (int i = 0; i < 4; ++i) { const int d = 16 * dt + 4 * fg + i; if (e < 64) oc[d * 64 + e] = accC[k][i]; else if (e == 64) on[d] = accC[k][i]; } } }
        if (tid == 0) A.out[(dir ? O_MB : O_MF) + b * 8 + h] = m_prev;
    }
}

constexpr int AT_K = 0, AT_VT = 9216, AT_END = 18432;
__device__ __forceinline__ void rope_freqs(float (&f)[8], int base) {
#pragma unroll
    for (int j = 0; j < 8; ++j) f[j] = exp2f(-(float)((base + j) & 15) * (13.287712379549449f / 16.f));
}
__device__ __forceinline__ void attn_unit(const Args& A, LAS unsigned char* lds, int latent, int b, int hq, int qb) {
    const int tid = threadIdx.x, lane = tid & 63, wave = __builtin_amdgcn_readfirstlane(tid >> 6), fr = lane & 15, fg = lane >> 4;
    const bf16* U = (const bf16*)(A.ws + WS_ACT); bf16* MIX = (bf16*)(A.ws + WS_MIX);
    const int kv = hq >> 2, rowbase = latent ? MP + b * LS : b * LP;
    const int qpos = qb * 128 + 16 * wave + fr, qrow = rowbase + qpos;
    bf16x8 qb0, qb1;
    {
        const v4u q0 = *(const v4u*)(U + (size_t)qrow * NOP + C_QA + hq * 64 + 8 * fg), q1 = *(const v4u*)(U + (size_t)qrow * NOP + C_QA + hq * 64 + 32 + 8 * fg);
        const unsigned a[4] = {q0.x, q0.y, q0.z, q0.w}, c[4] = {q1.x, q1.y, q1.z, q1.w};
        float x1[8], x2[8];
#pragma unroll
        for (int j = 0; j < 4; ++j) { x1[2 * j] = bflo(a[j]); x1[2 * j + 1] = bfhi(a[j]); x2[2 * j] = bflo(c[j]); x2[2 * j + 1] = bfhi(c[j]); }
        if (latent) { float fq[8]; rope_freqs(fq, 8 * fg); const float p = (fg < 2) ? (float)(qpos >> 6) : (float)(qpos & 63);
#pragma unroll
            for (int j = 0; j < 8; ++j) { const float sn = __sinf(p * fq[j]), cs = __cosf(p * fq[j]); const float y1 = x1[j] * cs - x2[j] * sn, y2 = x1[j] * sn + x2[j] * cs; x1[j] = y1; x2[j] = y2; } }
        v4u o0, o1; o0.x = pk2(x1[0] * 0.125f, x1[1] * 0.125f); o0.y = pk2(x1[2] * 0.125f, x1[3] * 0.125f); o0.z = pk2(x1[4] * 0.125f, x1[5] * 0.125f); o0.w = pk2(x1[6] * 0.125f, x1[7] * 0.125f);
        o1.x = pk2(x2[0] * 0.125f, x2[1] * 0.125f); o1.y = pk2(x2[2] * 0.125f, x2[3] * 0.125f); o1.z = pk2(x2[4] * 0.125f, x2[5] * 0.125f); o1.w = pk2(x2[6] * 0.125f, x2[7] * 0.125f);
        qb0 = __builtin_bit_cast(bf16x8, o0); qb1 = __builtin_bit_cast(bf16x8, o1);
    }
    f32x4 O[4];
#pragma unroll
    for (int dt = 0; dt < 4; ++dt) O[dt] = (f32x4){0.f, 0.f, 0.f, 0.f};
    float m_run = -1e30f, l_run = 0.f;
    const int nctx = latent ? 8 : 0;
    const int lat0 = latent ? (qb > 0 ? (qb - 1) * 2 : 0) : 0, lat1 = latent ? ((qb + 2) * 2 < LS / 64 ? (qb + 2) * 2 : LS / 64) : LP / 64;
    const int ntiles = nctx + (lat1 - lat0);
    f32x4 rka, rkc, rva, rvc;
    const int skey = tid >> 3, scc = tid & 7, vkey = tid & 63, vdc = tid >> 6;
#define AT_KT(ti_) ((ti_) < nctx ? (ti_) : lat0 + ((ti_) - nctx))
#define AT_LOAD(ti_) do { const int kt_ = AT_KT(ti_); \
        if ((ti_) < nctx) { const float* kp_ = A.in[I_CK] + ((size_t)(b * 2 + kv) * 512 + kt_ * 64 + skey) * 64 + 4 * scc; rka = *(const f32x4*)kp_; rkc = *(const f32x4*)(kp_ + 32); \
            const float* vp_ = A.in[I_CV] + ((size_t)(b * 2 + kv) * 512 + kt_ * 64 + vkey) * 64 + 8 * vdc; rva = *(const f32x4*)vp_; rvc = *(const f32x4*)(vp_ + 4); } \
        else { const bf16* kp_ = U + (size_t)(rowbase + kt_ * 64 + skey) * NOP + C_KA + kv * 64 + 4 * scc; const v2u a_ = *(const v2u*)kp_, c_ = *(const v2u*)(kp_ + 32); \
            rka.x = __uint_as_float(a_.x); rka.y = __uint_as_float(a_.y); rkc.x = __uint_as_float(c_.x); rkc.y = __uint_as_float(c_.y); \
            rva = *(const f32x4*)(U + (size_t)(rowbase + kt_ * 64 + vkey) * NOP + C_VA + kv * 64 + 8 * vdc); } \
    } while (0)
    AT_LOAD(0);
    for (int ti = 0; ti < ntiles; ++ti) {
        const bool from_cache = ti < nctx; const int kt = AT_KT(ti);
        { float x1[4], x2[4];
          if (from_cache) {
#pragma unroll
              for (int j = 0; j < 4; ++j) { x1[j] = rka[j]; x2[j] = rkc[j]; } }
          else { const unsigned ax = __float_as_uint(rka.x), ay = __float_as_uint(rka.y), cx = __float_as_uint(rkc.x), cy = __float_as_uint(rkc.y);
              x1[0] = bflo(ax); x1[1] = bfhi(ax); x1[2] = bflo(ay); x1[3] = bfhi(ay); x2[0] = bflo(cx); x2[1] = bfhi(cx); x2[2] = bflo(cy); x2[3] = bfhi(cy);
              if (latent) { const int kpos = kt * 64 + skey; const float p = (scc < 4) ? (float)(kpos >> 6) : (float)(kpos & 63);
#pragma unroll
                  for (int j = 0; j < 4; ++j) { const float f = exp2f(-(float)((4 * scc + j) & 15) * (13.287712379549449f / 16.f)); const float sn = __sinf(p * f), cs = __cosf(p * f);
                      const float y1 = x1[j] * cs - x2[j] * sn, y2 = x1[j] * sn + x2[j] * cs; x1[j] = y1; x2[j] = y2; } } }
          v2u w1, w2; w1.x = pk2(x1[0], x1[1]); w1.y = pk2(x1[2], x1[3]); w2.x = pk2(x2[0], x2[1]); w2.y = pk2(x2[2], x2[3]);
          *(LAS v2u*)(lds + AT_K + skey * 144 + 8 * scc) = w1; *(LAS v2u*)(lds + AT_K + skey * 144 + 64 + 8 * scc) = w2; }
        { unsigned short vb[8];
          if (from_cache) {
#pragma unroll
              for (int j = 0; j < 4; ++j) { vb[j] = (unsigned short)f2bf(rva[j]); vb[4 + j] = (unsigned short)f2bf(rvc[j]); } }
          else {
#pragma unroll
              for (int j = 0; j < 4; ++j) { const unsigned w_ = __float_as_uint(rva[j]); vb[2 * j] = (unsigned short)(w_ & 0xffffu); vb[2 * j + 1] = (unsigned short)(w_ >> 16); } }
#pragma unroll
          for (int j = 0; j < 8; ++j) *(LAS bf16*)(lds + AT_VT + (8 * vdc + j) * 144 + vkey * 2) = vb[j]; }
        __syncthreads();
        if (ti + 1 < ntiles) AT_LOAD(ti + 1);
        f32x4 S[4]; float tmax = -INFINITY;
#pragma unroll
        for (int st = 0; st < 4; ++st) { S[st] = (f32x4){0.f, 0.f, 0.f, 0.f};
            const bf16x8 ka0 = *(const LAS bf16x8*)(lds + AT_K + (16 * st + fr) * 144 + 16 * fg), ka1 = *(const LAS bf16x8*)(lds + AT_K + (16 * st + fr) * 144 + 64 + 16 * fg);
            S[st] = MFMA16(ka0, qb0, S[st]); S[st] = MFMA16(ka1, qb1, S[st]);
            if (latent && !from_cache) {
#pragma unroll
                for (int i = 0; i < 4; ++i) { const int kpos = kt * 64 + 16 * st + 4 * fg + i; const int dlt = kpos - qpos; if (dlt > 128 || dlt < -128) S[st][i] = -INFINITY; } }
#pragma unroll
            for (int i = 0; i < 4; ++i) tmax = fmaxf(tmax, S[st][i]); }
        tmax = fmaxf(tmax, __shfl_xor(tmax, 16)); tmax = fmaxf(tmax, __shfl_xor(tmax, 32));
        const float m_new = fmaxf(m_run, tmax); const float alpha = __expf(m_run - m_new); m_run = m_new;
        float psum = 0.f;
#pragma unroll
        for (int st = 0; st < 4; ++st)
#pragma unroll
            for (int i = 0; i < 4; ++i) { const float p = __expf(S[st][i] - m_new); S[st][i] = p; psum += p; }
        l_run = l_run * alpha + psum;
#pragma unroll
        for (int dt = 0; dt < 4; ++dt) O[dt] = O[dt] * alpha;
#pragma unroll
        for (int pr = 0; pr < 2; ++pr) { v2u plo, phi; plo.x = pk2(S[2 * pr][0], S[2 * pr][1]); plo.y = pk2(S[2 * pr][2], S[2 * pr][3]); phi.x = pk2(S[2 * pr + 1][0], S[2 * pr + 1][1]); phi.y = pk2(S[2 * pr + 1][2], S[2 * pr + 1][3]);
            const bf16x8 pb = cat44(plo, phi);
#pragma unroll
            for (int dt = 0; dt < 4; ++dt) { const LAS unsigned char* vp = lds + AT_VT + (16 * dt + fr) * 144;
                const v2u a_lo = *(const LAS v2u*)(vp + (32 * pr + 4 * fg) * 2), a_hi = *(const LAS v2u*)(vp + (32 * pr + 16 + 4 * fg) * 2);
                O[dt] = MFMA16(cat44(a_lo, a_hi), pb, O[dt]); } }
        __syncthreads();
    }
    l_run += __shfl_xor(l_run, 16); l_run += __shfl_xor(l_run, 32);
    l_run += __expf(A.in[I_SINK][hq] - m_run);
    const float inv = 1.f / l_run;
    bf16* op = MIX + (size_t)qrow * D + hq * 64 + 4 * fg;
#pragma unroll
    for (int dt = 0; dt < 4; ++dt) { v2u w; w.x = pk2(O[dt][0] * inv, O[dt][1] * inv); w.y = pk2(O[dt][2] * inv, O[dt][3] * inv); *(v2u*)(op + 16 * dt) = w; }
}

__device__ __forceinline__ void phase_odd_mixer(const Args& A, LAS unsigned char* lds) {
    const int G = gridDim.x;
    constexpr int N_ML = 32, N_AL = 128, N_MC = 512, N_AC = 512, NU = N_ML + N_MC + N_AL + N_AC;
    unsigned* qctr = (unsigned*)A.ws + 3584;
    volatile LAS unsigned* qslot = (volatile LAS unsigned*)(lds + 131072 + 384);
    for (;;) {
        if (threadIdx.x == 0) *qslot = __hip_atomic_fetch_add(qctr, 1u, __ATOMIC_RELAXED, __HIP_MEMORY_SCOPE_AGENT);
        __syncthreads();
        const int u = (int)*qslot;
        __syncthreads();
        if (u >= NU) break;
        int r = u;
        if (r < N_ML) { mlstm_unit(A, lds, 1, r >> 4, (r >> 1) & 7, r & 1); }
        else if ((r -= N_ML) < N_AL) { attn_unit(A, lds, 1, r >> 6, (r >> 3) & 7, r & 7); }
        else if ((r -= N_AL) < N_MC) { mlstm_unit(A, lds, 0, r >> 4, (r >> 1) & 7, r & 1); }
        else { r -= N_MC; attn_unit(A, lds, 0, r >> 4, (r >> 1) & 7, r & 1); }
        __syncthreads();
    }
    const bf16* U = (const bf16*)(A.ws + WS_ACT);
    for (int i = blockIdx.x * NTHR + threadIdx.x; i < MP * 64; i += G * NTHR) {
        const int row = i >> 6, c4 = (i & 63) * 4; const int b = row >> 8, t = row & 255;
        const v2u w = *(const v2u*)(U + (size_t)row * NOP + C_KA + c4);
        const f32x4 o = {bflo(w.x), bfhi(w.x), bflo(w.y), bfhi(w.y)};
        const int isv = c4 >> 7, kvh = (c4 >> 6) & 1, d = c4 & 63;
        *(f32x4*)(A.out + (isv ? O_CV : O_CK) + ((size_t)(b * 2 + kvh) * 256 + t) * 64 + d) = o;
    }
}
__device__ __forceinline__ void phase_readout(const Args& A) {
    const int lane = threadIdx.x & 63, gw = blockIdx.x * NWAVES + (threadIdx.x >> 6), NGW = gridDim.x * NWAVES;
    const bf16* U = (const bf16*)(A.ws + WS_ACT); bf16* MIX = (bf16*)(A.ws + WS_MIX); const float* HD = (const float*)(A.ws + WS_OP);
    for (int row = gw; row < M; row += NGW) {
        const float* h0 = HD + (size_t)row * 512 + 8 * lane; const float* h1 = h0 + (size_t)M * 512;
        f32x4 a0 = *(const f32x4*)h0 + *(const f32x4*)h1, a1 = *(const f32x4*)(h0 + 4) + *(const f32x4*)(h1 + 4);
        float s = (a0.x * a0.x + a0.y * a0.y) + (a0.z * a0.z + a0.w * a0.w) + (a1.x * a1.x + a1.y * a1.y) + (a1.z * a1.z + a1.w * a1.w);
        s += __shfl_xor(s, 1); s += __shfl_xor(s, 2); s += __shfl_xor(s, 4);
        const float rstd = rsqrtf(s * (1.f / 64.f) + EPS);
        const f32x4 g0 = *(const f32x4*)(A.in[I_HNG] + 8 * lane), g1 = *(const f32x4*)(A.in[I_HNG] + 8 * lane + 4);
        const v4u om = *(const v4u*)(U + (size_t)row * NOP + C_OM + 8 * lane);
        a0 = a0 * rstd * g0; a1 = a1 * rstd * g1;
        v4u o; o.x = pk2(a0.x * sigmoidf_(bflo(om.x)), a0.y * sigmoidf_(bfhi(om.x))); o.y = pk2(a0.z * sigmoidf_(bflo(om.y)), a0.w * sigmoidf_(bfhi(om.y)));
        o.z = pk2(a1.x * sigmoidf_(bflo(om.z)), a1.y * sigmoidf_(bfhi(om.z))); o.w = pk2(a1.z * sigmoidf_(bflo(om.w)), a1.w * sigmoidf_(bfhi(om.w)));
        *(v4u*)(MIX + (size_t)row * D + 512 + 8 * lane) = o;
    }
}
#ifndef MK_ONE_LAUNCH
#define MK_ONE_LAUNCH 1
#endif
constexpr int N_PHASES = 17;
constexpr int LDS_ST_OFF = 131072 + 320;
#define XB_TMO      128
#define XB_XCNT(j)  (256  + 64 * (j))
#define XB_XSUB(j)  (1280 + 64 * (j))
#define XB_XGEN(j)  (2304 + 64 * (j))
#define XB_TOP      3328
#define XB_TOPGEN   3392
#define XCD_BAR_WORDS 3456
#define XB_SPIN_CAP (1u << 18)

__device__ __forceinline__ unsigned xb_ld(unsigned* p)              { return __hip_atomic_load(p, __ATOMIC_RELAXED, __HIP_MEMORY_SCOPE_AGENT); }
__device__ __forceinline__ unsigned xb_add(unsigned* p, unsigned v) { return __hip_atomic_fetch_add(p, v, __ATOMIC_RELAXED, __HIP_MEMORY_SCOPE_AGENT); }
__device__ __forceinline__ unsigned xb_xcc_id() { return (unsigned)__builtin_amdgcn_s_getreg((3 << 11) | 20) & 0xFu; }
#define XB_SPIN(cond, bar) do { unsigned _sp = 0; while (cond) { __builtin_amdgcn_s_sleep(1); \
    if ((++_sp & 255u) == 0u) { if (xb_ld(&(bar)[XB_TMO])) break; if (_sp > XB_SPIN_CAP) { atomicAdd(&(bar)[XB_TMO], 1u); break; } } } } while (0)

struct XcdBarrier {
    unsigned* bar; unsigned x;
    volatile LAS unsigned* st;
};

__device__ __forceinline__ XcdBarrier xcd_barrier_post(unsigned* bar, volatile LAS unsigned* st) {
    XcdBarrier b; b.bar = bar; b.x = xb_xcc_id(); b.st = st;
    if (threadIdx.x == 0) (void)xb_add(&bar[XB_XCNT(b.x)], 1u);
    return b;
}
__device__ __forceinline__ void xcd_barrier_complete(unsigned* bar, unsigned x, unsigned& nloc, unsigned& nx) {
    const unsigned G = gridDim.x * gridDim.y * gridDim.z;
    unsigned sum, cnt, mine, sp = 0u;
    for (;;) {
        sum = 0u; cnt = 0u; mine = 0u;
#pragma unroll
        for (unsigned j = 0; j < 16; ++j) { const unsigned c = xb_ld(&bar[XB_XCNT(j)]); sum += c; cnt += (c > 0u) ? 1u : 0u; mine = (j == x) ? c : mine; }
        if (sum == G) break;
        __builtin_amdgcn_s_sleep(1);
        if ((++sp & 255u) == 0u) { if (xb_ld(&bar[XB_TMO])) break; if (sp > XB_SPIN_CAP) { atomicAdd(&bar[XB_TMO], 1u); break; } }
    }
    nloc = mine > 0u ? mine : 1u; nx = cnt > 0u ? cnt : 1u;
}

__device__ __forceinline__ void xcd_barrier(const XcdBarrier& b) {
    asm volatile("s_waitcnt vmcnt(0)" ::: "memory");
    __syncthreads();
    if (threadIdx.x == 0) {
        unsigned* bar = b.bar;
        __builtin_amdgcn_s_waitcnt(0);
        unsigned nloc = b.st[0], nx = b.st[1];
        if (nloc == 0u) { xcd_barrier_complete(bar, b.x, nloc, nx); b.st[0] = nloc; b.st[1] = nx; }
        const unsigned old = xb_add(&bar[XB_XSUB(b.x)], 1u);
        const unsigned gen = old / nloc;
        if (old + 1u == (gen + 1u) * nloc) {
            __builtin_amdgcn_fence(__ATOMIC_RELEASE, "agent");
            asm volatile("s_waitcnt vmcnt(0)" ::: "memory");
            const unsigned og = xb_add(&bar[XB_TOP], 1u);
            const unsigned tg = og / nx;
            if (og + 1u == (tg + 1u) * nx) xb_add(&bar[XB_TOPGEN], 1u);
            else XB_SPIN(xb_ld(&bar[XB_TOPGEN]) == tg, bar);
            __builtin_amdgcn_fence(__ATOMIC_ACQUIRE, "agent");
            xb_add(&bar[XB_XGEN(b.x)], 1u);
            asm volatile("s_waitcnt vmcnt(0)" ::: "memory");
        } else {
            XB_SPIN(xb_ld(&bar[XB_XGEN(b.x)]) == gen, bar);
            __builtin_amdgcn_fence(__ATOMIC_ACQUIRE, "agent");
            asm volatile("s_waitcnt vmcnt(0)" ::: "memory");
        }
    }
    __syncthreads();
}

__global__ void __launch_bounds__(NTHR, 2) fwd_megakernel(Args args) {
    extern __shared__ __attribute__((aligned(16))) unsigned char lds_raw[];
    LAS unsigned char* lds = (LAS unsigned char*)lds_raw;
    cg::grid_group grid = cg::this_grid();
    if (threadIdx.x < 4) ((LAS unsigned*)(lds + LDS_ST_OFF))[threadIdx.x] = 0u;
    __syncthreads();
    XcdBarrier bar; bar.bar = (unsigned*)args.ws; bar.x = 0; bar.st = nullptr;
    if (args.ph_hi - args.ph_lo > 1) bar = xcd_barrier_post((unsigned*)args.ws, (volatile LAS unsigned*)(lds + LDS_ST_OFF));
    if (args.ph_hi > 1000) grid.sync();
    unsigned char* ws = args.ws;
    bf16* H = (bf16*)(ws + WS_H); bf16* MIX = (bf16*)(ws + WS_MIX); float* OP = (float*)(ws + WS_OP); bf16* ACT = (bf16*)(ws + WS_ACT);
    const int lo = args.ph_lo, hi = args.ph_hi;
#define IN(k) (lo <= (k) && (k) < hi)
#define SEAM(k) do { if (lo <= (k) && (k) + 1 < hi) xcd_barrier(bar); } while (0)
#define GEMM_IN(l) do { const int N = (l) ? NOP : NE; \
        pg8::Gemm g{H, (const bf16*)(ws + ((l) ? WS_WOI : WS_WEI)), M, N, D}; pg8::StaticOrder S; S.init(M, N, (int)gridDim.x, (int)blockIdx.x); \
        pg8::EpiBf16<0> E{ACT, N}; pg8::gemm_phase<pg8::EpiBf16<0>, pg8::StaticOrder, true, true>(lds, g, S, E); } while (0)
#define GEMM_F32(Aptr, Wt, K) do { pg8::Gemm g{(Aptr), (const bf16*)(Wt), M, D, (K)}; pg8::StaticOrder S; S.init(M, D, (int)gridDim.x, (int)blockIdx.x); \
        pg8::EpiF32 E{OP, D}; pg8::gemm_phase<pg8::EpiF32, pg8::StaticOrder, true, true>(lds, g, S, E); } while (0)
#define GEMM_UP(l) do { pg8::Gemm g{H, (const bf16*)(ws + WS_W1 + (size_t)(l) * 8 * MiB), M, FF, D}; pg8::StaticOrder S; S.init(M, FF, (int)gridDim.x, (int)blockIdx.x); \
        pg8::EpiBf16<2> E{ACT, FF}; pg8::gemm_phase<pg8::EpiBf16<2>, pg8::StaticOrder, true, true>(lds, g, S, E); } while (0)
    if (IN(0)) phase_p0(args, lds);
    SEAM(0);
    if (IN(1)) phase_prenorm0(args);
    SEAM(1);
    if (IN(2)) GEMM_IN(0);
    SEAM(2);
    if (IN(3)) phase_even_mixer(args, lds);
    SEAM(3);
    if (IN(4)) GEMM_F32(MIX, ws + WS_WEO, D);
    SEAM(4);
    if (IN(5)) phase_post(args, 0, 0);
    SEAM(5);
    if (IN(6)) GEMM_UP(0);
    SEAM(6);
    if (IN(7)) GEMM_F32(ACT, ws + WS_W2, FF);
    SEAM(7);
    if (IN(8)) phase_post(args, 0, 1);
    SEAM(8);
    if (IN(9)) GEMM_IN(1);
    SEAM(9);
    if (IN(10)) phase_odd_mixer(args, lds);
    SEAM(10);
    if (IN(11)) phase_readout(args);
    SEAM(11);
    if (IN(12)) GEMM_F32(MIX, ws + WS_WOO, D);
    SEAM(12);
    if (IN(13)) phase_post(args, 1, 0);
    SEAM(13);
    if (IN(14)) GEMM_UP(1);
    SEAM(14);
    if (IN(15)) GEMM_F32(ACT, ws + WS_W2 + 8 * MiB, FF);
    SEAM(15);
    if (IN(16)) phase_post(args, 1, 1);
}

extern "C" void kernel_launch(void* const* d_in, const int* in_sizes, int n_in, void* d_out, int out_size, void* d_ws, size_t ws_size, hipStream_t stream) {
    static int grid = 0;
    if (grid == 0) {
        if (n_in != 29 || ws_size < WS_END) { fprintf(stderr, "kernel_launch: unexpected n_in %d / ws %zu\n", n_in, ws_size); grid = -1; return; }
        int dev = 0, cus = 0, per_cu = 0;
        hipGetDevice(&dev); hipDeviceGetAttribute(&cus, hipDeviceAttributeMultiprocessorCount, dev);
        if (hipFuncSetAttribute((const void*)fwd_megakernel, hipFuncAttributeMaxDynamicSharedMemorySize, LDS_BYTES) != hipSuccess) { fprintf(stderr, "kernel_launch: hipFuncSetAttribute failed\n"); grid = -1; return; }
        if (hipOccupancyMaxActiveBlocksPerMultiprocessor(&per_cu, (const void*)fwd_megakernel, NTHR, LDS_BYTES) != hipSuccess || per_cu < 1) { fprintf(stderr, "kernel_launch: occupancy query failed (%d)\n", per_cu); (void)hipGetLastError(); per_cu = 1; }
        if (per_cu > 1) per_cu = 1;
        grid = cus * per_cu;
    }
    if (grid < 0) return;
    if (hipMemsetAsync(d_ws, 0, 16384, stream) != hipSuccess) { fprintf(stderr, "kernel_launch: memset failed\n"); return; }
    Args a{};
    for (int i = 0; i < 29; ++i) a.in[i] = (const float*)d_in[i];
    a.out = (float*)d_out; a.ws = (unsigned char*)d_ws;
#if MK_ONE_LAUNCH
    a.ph_lo = 0; a.ph_hi = N_PHASES;
    void* kargs[] = {&a};
    hipError_t e = hipLaunchCooperativeKernel((const void*)fwd_megakernel, dim3(grid), dim3(NTHR), kargs, LDS_BYTES, stream);
    if (e != hipSuccess) fprintf(stderr, "cooperative launch failed: %s (grid %d)\n", hipGetErrorString(e), grid);
#else
    for (int ph = 0; ph < N_PHASES; ++ph) {
        a.ph_lo = ph; a.ph_hi = ph + 1;
        hipLaunchKernelGGL(fwd_megakernel, dim3(grid), dim3(NTHR), LDS_BYTES, stream, a);
    }
#endif
}
```
